# Optimizing an MI355X kernel written in HIP

```python
import math
import jax
import jax.numpy as jnp
from jax import lax
import numpy as np

D_MODEL = 1024
BATCH = 16
SEQ = 4096
DEPTH = 2
DEC_BATCH = 8
DEC_SEQ = 32
PAST_LEN = 2048

CHUNK = 64
EPS = 1e-6
D_PLE = 256
A_HEADS = 8
A_HEAD_DIM = 64
A_WIDTH = A_HEADS * A_HEAD_DIM
A_PREV_CHUNKS = 8
A_BAND = A_PREV_CHUNKS * CHUNK
REL_CLIP = 128
B_WIDTH = D_MODEL
B_HEAD_DIM = 64
B_HEADS = B_WIDTH // B_HEAD_DIM
B_GROUPS = 4
B_STATE = 64
B_CONV = 4
B_CONV_DIM = B_WIDTH + 2 * B_GROUPS * B_STATE
SSD_CHUNK = 64
C_WIDTH = D_MODEL // 2
C_BLOCKS = 8
C_BLOCK = C_WIDTH // C_BLOCKS
C_CONV = 4
C_RG = 8.0
N_BRANCH = 3
IN_SIZES = (A_WIDTH, A_WIDTH, A_WIDTH, A_WIDTH,
            B_WIDTH, B_CONV_DIM, B_HEADS,
            C_WIDTH, C_WIDTH,
            N_BRANCH * D_MODEL)
IN_TOTAL = sum(IN_SIZES)

kernel_name = 'hybrid_streaming_encoder_step'


def rms_norm(x, g):
    xf = x.astype(jnp.float32)
    y = xf * lax.rsqrt(jnp.mean(xf * xf, axis=-1, keepdims=True) + EPS)
    return (y * g.astype(jnp.float32)).astype(x.dtype)


def causal_dwconv(x, buf, w, b):
    width = w.shape[0]
    L = x.shape[1]
    xp = jnp.concatenate([buf.astype(x.dtype), x], axis=1)
    y = b.astype(x.dtype)
    for t in range(width):
        y = y + w[t].astype(x.dtype) * xp[:, t:t + L]
    return y, xp[:, L:]


def band_attend(q, k, v, q_pos, k_pos, rel_bias):
    qc = q_pos // CHUNK
    kc = jnp.floor_divide(k_pos, CHUNK)
    valid = ((kc[None, :] <= qc[:, None]) & (kc[None, :] >= qc[:, None] - A_PREV_CHUNKS)
             & (k_pos[None, :] >= 0))
    rel = jnp.clip(q_pos[:, None] - k_pos[None, :], -REL_CLIP, REL_CLIP) + REL_CLIP
    bias = rel_bias[:, rel].astype(jnp.float32)
    s = jnp.einsum('bqhd,bkhd->bhqk', q.astype(jnp.float32), k.astype(jnp.float32))
    s = s * (A_HEAD_DIM ** -0.5) + bias[None]
    s = jnp.where(valid[None, None], s, -1e30)
    pr = jax.nn.softmax(s, axis=-1)
    o = jnp.einsum('bhqk,bkhd->bqhd', pr, v.astype(jnp.float32))
    return o.astype(q.dtype)


def band_attention_prompt(q, k, v, rel_bias):
    b, L, h, d = q.shape
    nc = L // CHUNK
    pad = jnp.zeros((b, A_BAND, h, d), k.dtype)
    kp = jnp.concatenate([pad, k], axis=1)
    vp = jnp.concatenate([pad, v], axis=1)
    qch = jnp.moveaxis(q.reshape(b, nc, CHUNK, h, d), 1, 0)

    def one_chunk(args):
        c, qc_ = args
        start = c * CHUNK
        kb = lax.dynamic_slice_in_dim(kp, start, A_BAND + CHUNK, axis=1)
        vb = lax.dynamic_slice_in_dim(vp, start, A_BAND + CHUNK, axis=1)
        q_pos = start + jnp.arange(CHUNK)
        k_pos = start - A_BAND + jnp.arange(A_BAND + CHUNK)
        return band_attend(qc_, kb, vb, q_pos, k_pos, rel_bias)

    o = lax.map(one_chunk, (jnp.arange(nc), qch))
    return jnp.moveaxis(o, 0, 1).reshape(b, L, h, d)


def band_attention_sample(q, k, v, cache_k, cache_v, rel_bias, pos0):
    L = q.shape[1]
    a_len = cache_k.shape[1]
    k_all = jnp.concatenate([cache_k.astype(k.dtype), k], axis=1)
    v_all = jnp.concatenate([cache_v.astype(v.dtype), v], axis=1)
    q_pos = pos0 + jnp.arange(L)
    k_pos = jnp.concatenate([pos0 - a_len + jnp.arange(a_len), q_pos])
    return band_attend(q, k_all, v_all, q_pos, k_pos, rel_bias)


def ssd_scan(x, dt, a, bm, cm, h0):
    b, L, H, P = x.shape
    G, N = bm.shape[2], bm.shape[3]
    hpg = H // G
    cl = min(SSD_CHUNK, L)
    nc = L // cl
    xs = jnp.moveaxis(x.reshape(b, nc, cl, G, hpg, P), 1, 0)
    dts = jnp.moveaxis(dt.reshape(b, nc, cl, G, hpg), 1, 0)
    bs = jnp.moveaxis(bm.reshape(b, nc, cl, G, N), 1, 0)
    cs = jnp.moveaxis(cm.reshape(b, nc, cl, G, N), 1, 0)
    ag = a.reshape(G, hpg)
    tri = jnp.tril(jnp.ones((cl, cl), bool))[None, :, :, None, None]

    def step(h, inp):
        xc, dtc, bc, cc = inp
        cum = jnp.cumsum(dtc * ag, axis=1)
        seg = cum[:, :, None] - cum[:, None, :]
        decay = jnp.exp(jnp.where(tri, seg, -jnp.inf))
        cb = jnp.einsum('bign,bjgn->bijg', cc, bc)
        w = cb[..., None] * decay * dtc[:, None]
        y_in = jnp.einsum('bijgh,bjghp->bighp', w, xc)
        y_st = jnp.einsum('bign,bghpn->bighp', cc, h) * jnp.exp(cum)[..., None]
        dec_last = jnp.exp(cum[:, -1:] - cum) * dtc
        h_new = (h * jnp.exp(cum[:, -1])[..., None, None]
                 + jnp.einsum('bjghp,bjgn->bghpn', dec_last[..., None] * xc, bc))
        return h_new, y_in + y_st

    h_last, ys = lax.scan(step, h0.reshape(b, G, hpg, P, N), (xs, dts, bs, cs))
    y = jnp.moveaxis(ys, 0, 1).reshape(b, L, H, P)
    return y, h_last.reshape(b, H, P, N)


def rg_lru(xc, pos, w_r, b_r, w_i, b_i, lam, h0):
    b, L, W = xc.shape
    xf = xc.astype(jnp.float32)
    xb = xf.reshape(b, L, C_BLOCKS, C_BLOCK)
    r = jax.nn.sigmoid(jnp.einsum('blki,kij->blkj', xb, w_r.astype(jnp.float32)).reshape(b, L, W)
                       + b_r.astype(jnp.float32))
    i = jax.nn.sigmoid(jnp.einsum('blki,kij->blkj', xb, w_i.astype(jnp.float32)).reshape(b, L, W)
                       + b_i.astype(jnp.float32))
    log_a = -C_RG * r * jax.nn.softplus(-lam.astype(jnp.float32))
    a = jnp.exp(log_a)
    mult = jnp.sqrt(-jnp.expm1(2.0 * log_a))
    mult = jnp.where(pos[None, :, None] == 0, 1.0, mult)
    bt = mult * (i * xf)
    bt = bt.at[:, 0].add(a[:, 0] * h0.astype(jnp.float32))

    def comb(e1, e2):
        a1, b1 = e1
        a2, b2 = e2
        return a1 * a2, a2 * b1 + b2

    _, h = lax.associative_scan(comb, (a, bt), axis=1)
    return h, h[:, -1]


def layer(x, p, lw, cache_k, cache_v, conv_b, ssm_b, conv_c, lru_c, pos0, is_prompt):
    bsz, L, _ = x.shape
    dtp = x.dtype
    f32 = jnp.float32
    pos = pos0 + jnp.arange(L)
    h = rms_norm(x, lw['norm_g'])
    offs = np.cumsum(IN_SIZES)[:-1].tolist()
    q, k, v, g_a, z_b, xbc, dt_raw, g_c, x_c, g_mix = jnp.split(h @ lw['w_in'], offs, axis=-1)

    q = rms_norm(q.reshape(bsz, L, A_HEADS, A_HEAD_DIM), lw['qn_g'])
    k = rms_norm(k.reshape(bsz, L, A_HEADS, A_HEAD_DIM), lw['kn_g'])
    v = v.reshape(bsz, L, A_HEADS, A_HEAD_DIM)
    if is_prompt:
        o_a = band_attention_prompt(q, k, v, lw['rel_bias'])
        keep = min(A_BAND, L)
        new_k, new_v = k[:, L - keep:], v[:, L - keep:]
    else:
        o_a = band_attention_sample(q, k, v, cache_k, cache_v, lw['rel_bias'], pos0)
        new_k, new_v = k, v
    o_a = o_a.reshape(bsz, L, A_WIDTH) * jax.nn.silu(g_a)

    xbc, new_conv_b = causal_dwconv(xbc, conv_b, lw['conv_w_b'], lw['conv_b_b'])
    xbc = jax.nn.silu(xbc)
    xs, bm, cm = jnp.split(xbc, [B_WIDTH, B_WIDTH + B_GROUPS * B_STATE], axis=-1)
    dt = jax.nn.softplus(dt_raw.astype(f32) + lw['dt_bias'].astype(f32))
    a = -jnp.exp(lw['a_log'].astype(f32))
    xs_h = xs.reshape(bsz, L, B_HEADS, B_HEAD_DIM).astype(f32)
    y_b, new_ssm = ssd_scan(xs_h, dt, a,
                            bm.reshape(bsz, L, B_GROUPS, B_STATE).astype(f32),
                            cm.reshape(bsz, L, B_GROUPS, B_STATE).astype(f32),
                            ssm_b.astype(f32))
    y_b = y_b + lw['d_skip'].astype(f32)[:, None] * xs_h
    y_b = (y_b.reshape(bsz, L, B_WIDTH).astype(dtp) * jax.nn.silu(z_b)).reshape(bsz, L, B_GROUPS, -1)
    o_b = rms_norm(y_b, lw['ssm_norm_g'].reshape(B_GROUPS, -1)).reshape(bsz, L, B_WIDTH)

    x_c, new_conv_c = causal_dwconv(x_c, conv_c, lw['conv_w_c'], lw['conv_b_c'])
    h_c, new_lru = rg_lru(x_c, pos, lw['w_rg'], lw['b_rg'], lw['w_ig'], lw['b_ig'], lw['lru_lambda'], lru_c)
    o_c = h_c.astype(dtp) * jax.nn.silu(g_c)

    gates = jax.nn.sigmoid(g_mix).reshape(bsz, L, N_BRANCH, D_MODEL)
    mix = (gates[:, :, 0] * (o_a @ lw['w_oa']) + gates[:, :, 1] * (o_b @ lw['w_ob'])
           + gates[:, :, 2] * (o_c @ lw['w_oc']))
    x = x + mix @ lw['w_out']

    u = rms_norm(x, lw['ple_norm_g'])
    x = x + jax.nn.sigmoid(u @ lw['w_ple_gate']) * (p.astype(dtp) @ lw['w_ple_proj'])
    return x, (new_k, new_v, new_conv_b, new_ssm, new_conv_c, new_lru)


def setup_inputs(seed: int = 0) -> dict:
    key = jax.random.key(seed)
    keys = jax.random.split(key, 48)

    def nrm(i, shape, scale):
        return jax.random.normal(keys[i], shape, jnp.float32) * scale

    def uni(i, shape, lo, hi):
        return jax.random.uniform(keys[i], shape, jnp.float32, lo, hi)

    nd = DEPTH
    a_len = min(A_BAND, PAST_LEN)
    dt0 = jnp.exp(uni(20, (nd, B_HEADS), math.log(1e-3), math.log(1e-1)))
    u = uni(27, (nd, C_WIDTH), 0.9, 0.999)
    return {
        'x_prompt': nrm(0, (BATCH, SEQ, D_MODEL), 1.0),
        'x_sample': nrm(1, (DEC_BATCH, DEC_SEQ, D_MODEL), 1.0),
        'cache_k_a': nrm(2, (nd, DEC_BATCH, a_len, A_HEADS, A_HEAD_DIM), 1.0),
        'cache_v_a': nrm(3, (nd, DEC_BATCH, a_len, A_HEADS, A_HEAD_DIM), 1.0),
        'state_conv_b': nrm(4, (nd, DEC_BATCH, B_CONV - 1, B_CONV_DIM), 1.0),
        'state_ssm_b': nrm(5, (nd, DEC_BATCH, B_HEADS, B_HEAD_DIM, B_STATE), 0.3),
        'state_conv_c': nrm(6, (nd, DEC_BATCH, C_CONV - 1, C_WIDTH), 1.0),
        'state_lru_c': nrm(7, (nd, DEC_BATCH, C_WIDTH), 0.5),
        'p_prompt': nrm(8, (nd, BATCH, SEQ, D_PLE), 1.0),
        'p_sample': nrm(9, (nd, DEC_BATCH, DEC_SEQ, D_PLE), 1.0),
        'norm_g': 1.0 + nrm(10, (nd, D_MODEL), 0.05),
        'w_in': nrm(11, (nd, D_MODEL, IN_TOTAL), D_MODEL ** -0.5),
        'qn_g': 1.0 + nrm(12, (nd, A_HEAD_DIM), 0.05),
        'kn_g': 1.0 + nrm(13, (nd, A_HEAD_DIM), 0.05),
        'rel_bias': nrm(14, (nd, A_HEADS, 2 * REL_CLIP + 1), 0.3),
        'conv_w_b': nrm(15, (nd, B_CONV, B_CONV_DIM), B_CONV ** -0.5),
        'conv_b_b': nrm(16, (nd, B_CONV_DIM), 0.02),
        'dt_bias': dt0 + jnp.log(-jnp.expm1(-dt0)),
        'a_log': jnp.log(uni(21, (nd, B_HEADS), 1.0, 16.0)),
        'd_skip': 1.0 + nrm(22, (nd, B_HEADS), 0.1),
        'ssm_norm_g': 1.0 + nrm(23, (nd, B_WIDTH), 0.05),
        'conv_w_c': nrm(24, (nd, C_CONV, C_WIDTH), C_CONV ** -0.5),
        'conv_b_c': nrm(25, (nd, C_WIDTH), 0.02),
        'w_rg': nrm(26, (nd, C_BLOCKS, C_BLOCK, C_BLOCK), C_BLOCK ** -0.5),
        'b_rg': nrm(28, (nd, C_WIDTH), 0.02),
        'w_ig': nrm(29, (nd, C_BLOCKS, C_BLOCK, C_BLOCK), C_BLOCK ** -0.5),
        'b_ig': nrm(30, (nd, C_WIDTH), 0.02),
        'lru_lambda': jnp.log(u) - jnp.log1p(-u),
        'w_oa': nrm(31, (nd, A_WIDTH, D_MODEL), A_WIDTH ** -0.5),
        'w_ob': nrm(32, (nd, B_WIDTH, D_MODEL), B_WIDTH ** -0.5),
        'w_oc': nrm(33, (nd, C_WIDTH, D_MODEL), C_WIDTH ** -0.5),
        'w_out': nrm(34, (nd, D_MODEL, D_MODEL), D_MODEL ** -0.5),
        'ple_norm_g': 1.0 + nrm(35, (nd, D_MODEL), 0.05),
        'w_ple_gate': nrm(36, (nd, D_MODEL, D_MODEL), D_MODEL ** -0.5),
        'w_ple_proj': nrm(37, (nd, D_PLE, D_MODEL), D_PLE ** -0.5),
    }


def reference(x_prompt, x_sample, cache_k_a, cache_v_a, state_conv_b, state_ssm_b, state_conv_c,
              state_lru_c, p_prompt, p_sample, norm_g, w_in, qn_g, kn_g, rel_bias, conv_w_b, conv_b_b,
              dt_bias, a_log, d_skip, ssm_norm_g, conv_w_c, conv_b_c, w_rg, b_rg, w_ig, b_ig,
              lru_lambda, w_oa, w_ob, w_oc, w_out, ple_norm_g, w_ple_gate, w_ple_proj):
    def weights(i):
        return {'norm_g': norm_g[i], 'w_in': w_in[i], 'qn_g': qn_g[i], 'kn_g': kn_g[i],
                'rel_bias': rel_bias[i], 'conv_w_b': conv_w_b[i], 'conv_b_b': conv_b_b[i],
                'dt_bias': dt_bias[i], 'a_log': a_log[i], 'd_skip': d_skip[i],
                'ssm_norm_g': ssm_norm_g[i], 'conv_w_c': conv_w_c[i], 'conv_b_c': conv_b_c[i],
                'w_rg': w_rg[i], 'b_rg': b_rg[i], 'w_ig': w_ig[i], 'b_ig': b_ig[i],
                'lru_lambda': lru_lambda[i], 'w_oa': w_oa[i], 'w_ob': w_ob[i], 'w_oc': w_oc[i],
                'w_out': w_out[i], 'ple_norm_g': ple_norm_g[i], 'w_ple_gate': w_ple_gate[i],
                'w_ple_proj': w_ple_proj[i]}

    bp = x_prompt.shape[0]
    zero_conv_b = jnp.zeros((bp, B_CONV - 1, B_CONV_DIM), x_prompt.dtype)
    zero_ssm = jnp.zeros((bp, B_HEADS, B_HEAD_DIM, B_STATE), jnp.float32)
    zero_conv_c = jnp.zeros((bp, C_CONV - 1, C_WIDTH), x_prompt.dtype)
    zero_lru = jnp.zeros((bp, C_WIDTH), jnp.float32)
    y_prompt = x_prompt
    outs_p = []
    for i in range(DEPTH):
        y_prompt, st = layer(y_prompt, p_prompt[i], weights(i), None, None, zero_conv_b, zero_ssm,
                             zero_conv_c, zero_lru, 0, True)
        outs_p.append(st)

    y_sample = x_sample
    outs_s = []
    for i in range(DEPTH):
        y_sample, st = layer(y_sample, p_sample[i], weights(i), cache_k_a[i], cache_v_a[i],
                             state_conv_b[i], state_ssm_b[i], state_conv_c[i], state_lru_c[i],
                             PAST_LEN, False)
        outs_s.append(st)

    pk, pv, pcb, pss, pcc, plr = [jnp.stack(s) for s in zip(*outs_p)]
    sk, sv, scb, sss, scc, slr = [jnp.stack(s) for s in zip(*outs_s)]
    return (y_prompt, y_sample, pk, pv, pcb, pss, pcc, plr, sk, sv, scb, sss, scc, slr)
```

```cpp
#include <hip/hip_runtime.h>
#include <hip/hip_cooperative_groups.h>
#include <cstdio>
namespace cg = cooperative_groups;
namespace pg8 {
#define PG8_LAS __attribute__((address_space(3)))
typedef unsigned short bf16_t;
typedef short bf16x8 __attribute__((ext_vector_type(8)));
typedef float f32x4 __attribute__((ext_vector_type(4)));
typedef unsigned u32x4 __attribute__((ext_vector_type(4)));
constexpr int BM = 256, BK = 64, HALF = 128, HTB = HALF * BK * 2  , STAGE_BYTES = 8 * HTB, NXCD = 8, WGM = 8;

__host__ __device__ __forceinline__ int lds_byte(int r, int c) { const int st = (r >> 4) * 2 + (c >> 5), rr = r & 15, cc = c & 31, ob = rr * 64 + cc * 2; return st * 1024 + (ob ^ (((ob >> 9) & 1) << 5)); }
__host__ __device__ __forceinline__ void stage_rc(int b, int& R, int& C) { const int st = b / 1024, sb = b % 1024, swz = sb ^ (((sb >> 9) & 1) << 5); R = (st >> 1) * 16 + swz / 64; C = (st & 1) * 32 + (swz % 64) / 2; }
__host__ __device__ __forceinline__ int perm32(int rho) { const int n = rho >> 4, i = rho & 15; return 8 * (i >> 2) + 4 * n + (i & 3); }

struct Unit { int pm, pn; };
struct Gemm { const bf16_t* A; const bf16_t* Bt; int M, N, K, wv; };
struct StaticOrder {
    int nM, nN, nwg, G, c;
    __host__ __device__ void init(int M, int N, int G_, int c_) { nM = M / BM; nN = N / BM; nwg = nM * nN; G = G_; c = c_; }
    __host__ __device__ bool next(int i, Unit& u) const {
        const long L = (long)i * G + c; if (L >= nwg) return false;
        int wgid = (int)L; { const int q = nwg / NXCD, r = nwg % NXCD, xcd = wgid % NXCD, off = wgid / NXCD; wgid = (xcd < r ? xcd * (q + 1) : r * (q + 1) + (xcd - r) * q) + off; }
        const int nig = WGM * nN, gid = wgid / nig, fm = gid * WGM, gsz = (nM - fm) < WGM ? (nM - fm) : WGM;
        u.pm = fm + ((wgid % nig) % gsz); u.pn = (wgid % nig) / gsz; return true;
    }
    __device__ __forceinline__ void a_ready(const Unit&) const {}
    __device__ __forceinline__ void done(const Unit&) const {}
};
__device__ __forceinline__ unsigned cvt_pk_bf16(float lo, float hi) { unsigned r; asm volatile("v_cvt_pk_bf16_f32 %0, %1, %2" : "=v"(r) : "v"(lo), "v"(hi)); return r; }
template <class Epi, class Sched, bool STAMP = false>
__device__ __forceinline__ void gemm_phase(PG8_LAS unsigned char* lds, const Gemm g, const Sched& S, const Epi& E, unsigned long long* stamps) {
    int tid_; asm volatile("v_mbcnt_lo_u32_b32 %0, -1, 0\n\tv_mbcnt_hi_u32_b32 %0, -1, %0" : "=v"(tid_)); tid_ += g.wv * 64; const int tid = tid_, wid = __builtin_amdgcn_readfirstlane(tid >> 6), lane = tid & 63, wr = wid >> 2, wc = wid & 3, fr = lane & 15, fq = lane >> 4;
    const int K = g.K, nt = K / BK;
    int ts_lo = 0, ts_hi = 0, nts = 0; const unsigned long long rt_entry = STAMP ? (unsigned long long)wall_clock64() : 0ull;
#define PG8_STAMP() do { if (STAMP && wid == 0 && nts < 64) { const unsigned long long _c = (unsigned long long)clock64(); \
        ts_lo = (lane == nts) ? (int)(unsigned)_c : ts_lo; ts_hi = (lane == nts) ? (int)(unsigned)(_c >> 32) : ts_hi; ++nts; } } while (0)
    PG8_STAMP();
    unsigned voffA[2], voffB[2];
#pragma unroll
    for (int i = 0; i < 2; ++i) { int R, C; stage_rc(tid * 16 + i * 8192, R, C); const int Rb = Epi::PERM ? ((R & ~31) + perm32(R & 31)) : R;
        voffA[i] = (unsigned)(R * K + C) * 2u; voffB[i] = (unsigned)(Rb * K + C) * 2u; }
    const size_t kstep = (size_t)(BK * 2);
    const size_t hstep = (size_t)HALF * K * 2;
    const size_t tstep = 2 * hstep;
    const unsigned ldsw = (unsigned)wid * 1024u;
    const int aoff = lds_byte(wr * 64 + fr, fq * 8), boff = lds_byte(wc * 32 + fr, fq * 8);
#define PG8_SA(b, h) (((b) * 2 + (h)) * HTB)
#define PG8_SB(b, h) ((4 + (b) * 2 + (h)) * HTB)
#define PG8_STAGE(bufoff, gbase, voff) do { _Pragma("unroll") for (int _i = 0; _i < 2; ++_i) \
        __builtin_amdgcn_global_load_lds((const unsigned*)((const char*)(gbase) + (voff)[_i]), (PG8_LAS unsigned*)(lds + (bufoff) + ldsw + _i * 8192), 16, 0, 0); } while (0)
#define PG8_LDA(dst, b, h) do { _Pragma("unroll") for (int m = 0; m < 4; ++m) _Pragma("unroll") for (int k = 0; k < 2; ++k) dst[m][k] = *(const PG8_LAS bf16x8*)(lds + PG8_SA(b, h) + aoff + m * 2048 + k * 1024); } while (0)
#define PG8_LDB(dst, b, h) do { _Pragma("unroll") for (int n = 0; n < 2; ++n) _Pragma("unroll") for (int k = 0; k < 2; ++k) dst[n][k] = *(const PG8_LAS bf16x8*)(lds + PG8_SB(b, h) + boff + n * 2048 + k * 1024); } while (0)
#define PG8_MMA(ai, bj, At, Bt) do { __builtin_amdgcn_s_setprio(1); _Pragma("unroll") for (int m = 0; m < 4; ++m) _Pragma("unroll") for (int n = 0; n < 2; ++n) _Pragma("unroll") for (int k = 0; k < 2; ++k) \
        acc[ai][bj][m][n] = __builtin_amdgcn_mfma_f32_16x16x32_bf16(Bt[n][k], At[m][k], acc[ai][bj][m][n], 0, 0, 0); __builtin_amdgcn_s_setprio(0); } while (0)
#define PG8_WAIT_V(n) asm volatile("s_waitcnt vmcnt(" #n ")" ::: "memory")
#define PG8_WAIT_L(n) asm volatile("s_waitcnt lgkmcnt(" #n ")" ::: "memory")
#define PG8_BAR __builtin_amdgcn_s_barrier()
#define PG8_SCHED __builtin_amdgcn_sched_barrier(0)
    Unit cur, nxt; int ui = 0;
    if (!S.next(0, cur)) return;
    f32x4 acc[2][2][4][2];
#pragma unroll
    for (int a = 0; a < 2; ++a)
#pragma unroll
        for (int b = 0; b < 2; ++b)
#pragma unroll
            for (int m = 0; m < 4; ++m)
#pragma unroll
                for (int n = 0; n < 2; ++n) acc[a][b][m][n] = (f32x4){0.f, 0.f, 0.f, 0.f};
    bf16x8 At[4][2], B0[2][2], B1[2][2];
    const char* cA = (const char*)g.A + (size_t)cur.pm * tstep; const char* cB = (const char*)g.Bt + (size_t)cur.pn * tstep;
    S.a_ready(cur);
    PG8_STAGE(PG8_SB(0, 0), cB, voffB); PG8_STAGE(PG8_SA(0, 0), cA, voffA); PG8_STAGE(PG8_SB(0, 1), cB + hstep, voffB); PG8_STAGE(PG8_SA(0, 1), cA + hstep, voffA);
    if (wr == 1) PG8_BAR;
    PG8_WAIT_V(4); PG8_BAR;
    PG8_STAGE(PG8_SB(1, 0), cB + kstep, voffB); PG8_STAGE(PG8_SA(1, 0), cA + kstep, voffA); PG8_STAGE(PG8_SB(1, 1), cB + hstep + kstep, voffB);
    PG8_WAIT_V(6); PG8_BAR;
    PG8_STAMP();
    for (;;) {
        const bool has_next = S.next(ui + 1, nxt);
        const char* nA = has_next ? (const char*)g.A + (size_t)nxt.pm * tstep : cA; const char* nB = has_next ? (const char*)g.Bt + (size_t)nxt.pn * tstep : cB;
        for (int t = 0; t < nt; t += 2) {
            const bool last = (t == nt - 2);
            const char* a1 = cA + (size_t)(t + 1) * kstep;
            const char* a2 = last ? nA : cA + (size_t)(t + 2) * kstep; const char* b2 = last ? nB : cB + (size_t)(t + 2) * kstep;
            const char* a3 = a2 + kstep; const char* b3 = b2 + kstep;
            if (last && has_next) S.a_ready(nxt);
            PG8_LDB(B0, 0, 0); PG8_SCHED; PG8_LDA(At, 0, 0); PG8_STAGE(PG8_SA(1, 1), a1 + hstep, voffA);
            PG8_WAIT_L(8); PG8_BAR; PG8_WAIT_L(0); PG8_MMA(0, 0, At, B0); PG8_BAR; PG8_SCHED;
            PG8_LDB(B1, 0, 1); PG8_STAGE(PG8_SB(0, 0), b2, voffB);
            PG8_BAR; PG8_WAIT_L(0); PG8_MMA(0, 1, At, B1); PG8_BAR;
            PG8_LDA(At, 0, 1); PG8_STAGE(PG8_SA(0, 0), a2, voffA);
            PG8_BAR; PG8_WAIT_L(0); PG8_MMA(1, 0, At, B0); PG8_BAR; PG8_SCHED;
            PG8_STAGE(PG8_SB(0, 1), b2 + hstep, voffB);
            PG8_WAIT_V(6); PG8_BAR; PG8_MMA(1, 1, At, B1); PG8_BAR;
            PG8_LDB(B0, 1, 0); PG8_SCHED; PG8_LDA(At, 1, 0); PG8_STAGE(PG8_SA(0, 1), a2 + hstep, voffA);
            PG8_WAIT_L(8); PG8_BAR; PG8_WAIT_L(0); PG8_MMA(0, 0, At, B0); PG8_BAR; PG8_SCHED;
            PG8_LDB(B1, 1, 1); PG8_STAGE(PG8_SB(1, 0), b3, voffB);
            PG8_BAR; PG8_WAIT_L(0); PG8_MMA(0, 1, At, B1); PG8_BAR;
            PG8_LDA(At, 1, 1); PG8_STAGE(PG8_SA(1, 0), a3, voffA);
            PG8_BAR; PG8_WAIT_L(0); PG8_MMA(1, 0, At, B0); PG8_BAR; PG8_SCHED;
            PG8_STAGE(PG8_SB(1, 1), b3 + hstep, voffB);
            PG8_WAIT_V(6); PG8_BAR; PG8_MMA(1, 1, At, B1); PG8_BAR;
        }
        PG8_STAMP();
        if constexpr (!Epi::AFTER_DRAIN) { E(acc, cur, wr, wc, fr, fq); S.done(cur); }
        PG8_STAMP();
        if (!has_next) break;
#pragma unroll
        for (int a = 0; a < 2; ++a)
#pragma unroll
            for (int b = 0; b < 2; ++b)
#pragma unroll
                for (int m = 0; m < 4; ++m)
#pragma unroll
                    for (int n = 0; n < 2; ++n) acc[a][b][m][n] = (f32x4){0.f, 0.f, 0.f, 0.f};
        cur = nxt; cA = nA; cB = nB; ++ui;
    }
    PG8_WAIT_V(0);
    if (wr == 0) PG8_BAR;
    PG8_BAR;
    if constexpr (Epi::AFTER_DRAIN) { E.fused(acc, cur, wr, wc, fr, fq, lds, wid, lane); S.done(cur); }
    PG8_STAMP();
    if (STAMP && wid == 0) { stamps[lane] = lane < nts ? (((unsigned long long)(unsigned)ts_hi << 32) | (unsigned)ts_lo) : 0ull;
        if (lane == 62) stamps[62] = rt_entry; if (lane == 63) stamps[63] = (unsigned long long)wall_clock64(); }
#undef PG8_STAMP
#undef PG8_SA
#undef PG8_SB
#undef PG8_STAGE
#undef PG8_LDA
#undef PG8_LDB
#undef PG8_MMA
#undef PG8_WAIT_V
#undef PG8_WAIT_L
#undef PG8_BAR
#undef PG8_SCHED
}
}
using namespace pg8;
#ifndef EPI_MASK
#define EPI_MASK 31
#endif
#define GEMMCALL gemm_sel
template <class Epi, class Sched, bool X> __device__ __forceinline__ void gemm_sel(PG8_LAS unsigned char* lds, const Gemm g, const Sched& S, const Epi& E, unsigned long long* st) { if constexpr ((EPI_MASK & Epi::ID) != 0) gemm_phase<Epi, Sched, X>(lds, g, S, E, st); }
typedef unsigned u32x2 __attribute__((ext_vector_type(2)));

constexpr int DM = 1024, SEQ = 4096, NB = 16, NSB = 8, SL = 32;
constexpr int GB = 4, NG = NB / GB;
constexpr int MP = GB * SEQ;
constexpr int MSMP = NSB * SL;
constexpr int MLOC = MP + MSMP;
constexpr int NPROJ = 8704;
constexpr int NWIN = 8960;
constexpr int C_Q = 0, C_K = 512, C_V = 1024, C_GA = 1536, C_Z = 2048, C_XBC = 3072, C_GC = 4608, C_XC = 5120, C_GM = 5632;
constexpr float EPSN = 1e-6f;

constexpr size_t al256(size_t x) { return (x + 255) & ~(size_t)255; }
constexpr size_t WS_WIN = 0;
constexpr size_t WS_WOA = WS_WIN + al256((size_t)2 * NWIN * 1024 * 2);
constexpr size_t WS_WOB = WS_WOA + al256((size_t)2 * 1024 * 512 * 2);
constexpr size_t WS_WOC = WS_WOB + al256((size_t)2 * 1024 * 1024 * 2);
constexpr size_t WS_WOUT = WS_WOC + al256((size_t)2 * 1024 * 512 * 2);
constexpr size_t WS_WPG = WS_WOUT + al256((size_t)2 * 1024 * 1024 * 2);
constexpr size_t WS_WPP = WS_WPG + al256((size_t)2 * 1024 * 1024 * 2);
constexpr size_t WS_KC = WS_WPP + al256((size_t)2 * 1024 * 256 * 2);
constexpr size_t WS_VC = WS_KC + al256((size_t)2 * 8 * 512 * 512 * 2);
constexpr size_t WS_SS = WS_VC + al256((size_t)2 * 8 * 512 * 512 * 2);
constexpr size_t WS_CTR = WS_SS + al256((size_t)NG * 4 * MLOC * 4);
constexpr size_t WS_HBUF = WS_CTR + 1024;
constexpr size_t WS_PROJ = WS_HBUF + al256((size_t)MLOC * 1024 * 2);
constexpr size_t WS_DT = WS_PROJ + al256((size_t)MLOC * NPROJ * 2);
constexpr size_t WS_OA = WS_DT + al256((size_t)MLOC * 16 * 4);
constexpr size_t WS_OB = WS_OA + al256((size_t)MLOC * 512 * 2);
constexpr size_t WS_OC = WS_OB + al256((size_t)MLOC * 1024 * 2);
constexpr size_t WS_MIXF = WS_OC + al256((size_t)MLOC * 512 * 2);
constexpr size_t WS_MIXB = WS_MIXF + al256((size_t)MLOC * 1024 * 4);
constexpr size_t WS_UBUF = WS_MIXB + al256((size_t)MLOC * 1024 * 2);
constexpr size_t WS_PBUF = WS_UBUF + al256((size_t)MLOC * 1024 * 2);
constexpr size_t WS_PP = WS_PBUF + al256((size_t)2 * MLOC * 256 * 2);
constexpr size_t WS_END = WS_PP + al256((size_t)MLOC * 1024 * 2);

constexpr size_t O_YP = 0;
constexpr size_t O_YS = O_YP + (size_t)NB * SEQ * DM;
constexpr size_t O_PK = O_YS + (size_t)NSB * SL * DM;
constexpr size_t O_PV = O_PK + (size_t)2 * NB * 512 * 512;
constexpr size_t O_PCB = O_PV + (size_t)2 * NB * 512 * 512;
constexpr size_t O_PSS = O_PCB + (size_t)2 * NB * 3 * 1536;
constexpr size_t O_PCC = O_PSS + (size_t)2 * NB * 16 * 64 * 64;
constexpr size_t O_PLR = O_PCC + (size_t)2 * NB * 3 * 512;
constexpr size_t O_SK = O_PLR + (size_t)2 * NB * 512;
constexpr size_t O_SV = O_SK + (size_t)2 * NSB * SL * 512;
constexpr size_t O_SCB = O_SV + (size_t)2 * NSB * SL * 512;
constexpr size_t O_SSS = O_SCB + (size_t)2 * NSB * 3 * 1536;
constexpr size_t O_SCC = O_SSS + (size_t)2 * NSB * 16 * 64 * 64;
constexpr size_t O_SLR = O_SCC + (size_t)2 * NSB * 3 * 512;
constexpr size_t O_END = O_SLR + (size_t)2 * NSB * 512;

struct Params { const float* in[35]; float* out; unsigned char* ws; };
enum { I_XP = 0, I_XS, I_CK, I_CV, I_SCB, I_SSM, I_SCC, I_SLR, I_PP, I_PS, I_NG, I_WIN, I_QN, I_KN, I_RB, I_CWB, I_CBB, I_DTB, I_ALOG, I_DSK, I_SNG, I_CWC, I_CBC,
       I_WRG, I_BRG, I_WIG, I_BIG, I_LAM, I_WOA, I_WOB, I_WOC, I_WOUT, I_PNG, I_WPG, I_WPP };

#define KCONST __attribute__((address_space(4)))
__device__ __forceinline__ Params load_params() { auto p = __builtin_amdgcn_kernarg_segment_ptr(); asm volatile("" : "+s"(p)); Params r; const KCONST unsigned long long* q = (const KCONST unsigned long long*)p;
#pragma unroll
    for (int i = 0; i < 35; ++i) r.in[i] = (const float*)q[i];
    r.out = (float*)q[35]; r.ws = (unsigned char*)q[36]; return r; }
__device__ __forceinline__ int otid(int wv) { int t; asm volatile("v_mbcnt_lo_u32_b32 %0, -1, 0\n\tv_mbcnt_hi_u32_b32 %0, -1, %0" : "=v"(t)); return t + wv * 64; }
__device__ __forceinline__ float bflo(unsigned w) { return __uint_as_float(w << 16); }
__device__ __forceinline__ float bfhi(unsigned w) { return __uint_as_float(w & 0xffff0000u); }
__device__ __forceinline__ float bf1(bf16_t b) { return __uint_as_float(((unsigned)b) << 16); }
__device__ __forceinline__ bf16_t f2bf(float f) { return (bf16_t)(cvt_pk_bf16(f, 0.f) & 0xffffu); }
__device__ __forceinline__ float bperm(float v, int srclane) { return __int_as_float(__builtin_amdgcn_ds_bpermute(srclane << 2, __float_as_int(v))); }
__device__ __forceinline__ float wsum4(float v, int lane) { v += bperm(v, lane ^ 16); v += bperm(v, lane ^ 32); return v; }
__device__ __forceinline__ float wmax4(float v, int lane) { v = fmaxf(v, bperm(v, lane ^ 16)); v = fmaxf(v, bperm(v, lane ^ 32)); return v; }
__device__ __forceinline__ float sigmoidf_(float x) { return 1.0f / (1.0f + __expf(-x)); }
__device__ __forceinline__ float siluf_(float x) { return x / (1.0f + __expf(-x)); }
__device__ __forceinline__ float softplusf_(float x) { const float e = __expf(x); return x > 15.f ? x : (x < -5.f ? e * (1.0f - 0.5f * e) : __logf(1.0f + e)); }
__device__ __forceinline__ void unpack8(const u32x4 r, float (&f)[8]) { f[0] = bflo(r.x); f[1] = bfhi(r.x); f[2] = bflo(r.y); f[3] = bfhi(r.y); f[4] = bflo(r.z); f[5] = bfhi(r.z); f[6] = bflo(r.w); f[7] = bfhi(r.w); }
__device__ __forceinline__ u32x4 pack8(const float (&f)[8]) { u32x4 r; r.x = cvt_pk_bf16(f[0], f[1]); r.y = cvt_pk_bf16(f[2], f[3]); r.z = cvt_pk_bf16(f[4], f[5]); r.w = cvt_pk_bf16(f[6], f[7]); return r; }
__device__ __forceinline__ bf16x8 as_bf8(u32x4 r) { union { u32x4 u; bf16x8 b; } c; c.u = r; return c.b; }
#define MFMA16(a, b, c) __builtin_amdgcn_mfma_f32_16x16x32_bf16((a), (b), (c), 0, 0, 0)
#define MEMFENCE() asm volatile("" ::: "memory")
#define LDSWAIT() asm volatile("s_waitcnt lgkmcnt(0)" ::: "memory")

__device__ __forceinline__ const float* x_row(const Params& P, int g, int lr) { return lr < MP ? P.in[I_XP] + ((size_t)g * MP + lr) * DM : P.in[I_XS] + (size_t)(lr - MP) * DM; }
__device__ __forceinline__ float* y_row(const Params& P, int g, int lr) { return lr < MP ? P.out + O_YP + ((size_t)g * MP + lr) * DM : P.out + O_YS + (size_t)(lr - MP) * DM; }

struct EpiIn { static constexpr int ID = 1;
    static constexpr bool PERM = true, AFTER_DRAIN = false;
    bf16_t* proj; float* dtb; const float* ss;
    __device__ __forceinline__ void operator()(const f32x4 (&acc)[2][2][4][2], const Unit& u, int wr, int wc, int fr, int fq) const {
        const int row0 = u.pm * BM + wr * 64 + fr;
#pragma unroll
        for (int ai = 0; ai < 2; ++ai)
#pragma unroll
            for (int m = 0; m < 4; ++m) {
                const int row = row0 + ai * HALF + m * 16;
                const float r = rsqrtf(ss[row] * (1.0f / 1024.0f) + EPSN);
                if (u.pn < 34) {
                    bf16_t* rp = proj + (size_t)row * NPROJ + u.pn * BM + wc * 32 + 8 * fq;
#pragma unroll
                    for (int bj = 0; bj < 2; ++bj) { const f32x4 v0 = acc[ai][bj][m][0] * r, v1 = acc[ai][bj][m][1] * r;
                        u32x4 w; w.x = cvt_pk_bf16(v0[0], v0[1]); w.y = cvt_pk_bf16(v0[2], v0[3]); w.z = cvt_pk_bf16(v1[0], v1[1]); w.w = cvt_pk_bf16(v1[2], v1[3]);
                        *(u32x4*)(rp + bj * HALF) = w; }
                } else if (wc == 0 && fq < 2) {
                    float* dp = dtb + (size_t)row * 16 + 8 * fq;
                    *(f32x4*)dp = acc[ai][0][m][0] * r; *(f32x4*)(dp + 4) = acc[ai][0][m][1] * r;
                }
                MEMFENCE();
            }
    }
};
template <int MODE> struct EpiMerge { static constexpr int ID = 2;
    static constexpr bool PERM = false, AFTER_DRAIN = false;
    const bf16_t* gate; float* mixf; bf16_t* mixb;
    __device__ __forceinline__ void operator()(const f32x4 (&acc)[2][2][4][2], const Unit& u, int wr, int wc, int fr, int fq) const {
        const int lane = fr + 16 * fq; (void)lane;
        const unsigned row0 = u.pm * BM + wr * 64 + fr, col0 = u.pn * BM + wc * 32 + 4 * fq;
#pragma unroll
        for (int ai = 0; ai < 2; ++ai)
#pragma unroll
            for (int m = 0; m < 4; ++m) {
                const unsigned row = row0 + ai * HALF + m * 16;
                const unsigned go = row * NPROJ + col0, mo = row * DM + col0;
#pragma unroll
                for (int bj = 0; bj < 2; ++bj) {
#pragma unroll
                    for (int n = 0; n < 2; ++n) {
                        const unsigned cc = bj * HALF + n * 16;
                        const u32x2 gw = *(const u32x2*)(gate + go + cc);
                        f32x4 v = acc[ai][bj][m][n];
                        v[0] *= sigmoidf_(bflo(gw.x)); v[1] *= sigmoidf_(bfhi(gw.x)); v[2] *= sigmoidf_(bflo(gw.y)); v[3] *= sigmoidf_(bfhi(gw.y));
                        float* mp = mixf + mo + cc;
                        if (MODE >= 1) v += *(const f32x4*)mp;
                        if (MODE <= 1) *(f32x4*)mp = v;
                        else { u32x2 w; w.x = cvt_pk_bf16(v[0], v[1]); w.y = cvt_pk_bf16(v[2], v[3]); *(u32x2*)(mixb + mo + cc) = w; }
                    }
                    MEMFENCE();
                }
            }
    }
};
struct EpiOut { static constexpr int ID = 4;
    static constexpr bool PERM = false, AFTER_DRAIN = false;
    const float* xa; const float* xb; float* ya; float* yb; bf16_t* ub; const float* pg; float* ss;
    __device__ __forceinline__ void operator()(const f32x4 (&acc)[2][2][4][2], const Unit& u, int wr, int wc, int fr, int fq) const {
        const int lane = fr + 16 * fq; (void)lane;
        const unsigned row0 = u.pm * BM + wr * 64 + fr, col0 = u.pn * BM + wc * 32 + 4 * fq;
        const bool smp = (u.pm * BM) >= MP;
        const float* xbase = smp ? xb - (size_t)MP * DM : xa; float* ybase = smp ? yb - (size_t)MP * DM : ya;
#pragma unroll
        for (int ai = 0; ai < 2; ++ai)
#pragma unroll
            for (int m = 0; m < 4; ++m) {
                const unsigned row = row0 + ai * HALF + m * 16; const unsigned ro = row * DM + col0;
                float s = 0.f;
#pragma unroll
                for (int bj = 0; bj < 2; ++bj) {
#pragma unroll
                    for (int n = 0; n < 2; ++n) {
                        const unsigned cc = bj * HALF + n * 16;
                        const f32x4 v = *(const f32x4*)(xbase + ro + cc) + acc[ai][bj][m][n];
                        *(f32x4*)(ybase + ro + cc) = v;
                        s += (v[0] * v[0] + v[1] * v[1]) + (v[2] * v[2] + v[3] * v[3]);
                        const f32x4 q = v * *(const f32x4*)(pg + col0 + cc);
                        u32x2 w; w.x = cvt_pk_bf16(q[0], q[1]); w.y = cvt_pk_bf16(q[2], q[3]); *(u32x2*)(ub + ro + cc) = w;
                    }
                    MEMFENCE();
                }
                s = wsum4(s, lane);
                if (fq == 0) atomicAdd(ss + row, s);
            }
    }
};
struct EpiPP { static constexpr int ID = 8;
    static constexpr bool PERM = true, AFTER_DRAIN = false;
    bf16_t* pp;
    __device__ __forceinline__ void operator()(const f32x4 (&acc)[2][2][4][2], const Unit& u, int wr, int wc, int fr, int fq) const {
        const int row0 = u.pm * BM + wr * 64 + fr;
#pragma unroll
        for (int ai = 0; ai < 2; ++ai)
#pragma unroll
            for (int m = 0; m < 4; ++m) {
                bf16_t* rp = pp + (size_t)(row0 + ai * HALF + m * 16) * DM + u.pn * BM + wc * 32 + 8 * fq;
#pragma unroll
                for (int bj = 0; bj < 2; ++bj) { const f32x4 v0 = acc[ai][bj][m][0], v1 = acc[ai][bj][m][1];
                    u32x4 w; w.x = cvt_pk_bf16(v0[0], v0[1]); w.y = cvt_pk_bf16(v0[2], v0[3]); w.z = cvt_pk_bf16(v1[0], v1[1]); w.w = cvt_pk_bf16(v1[2], v1[3]);
                    *(u32x4*)(rp + bj * HALF) = w; }
                MEMFENCE();
            }
    }
};
struct EpiGate { static constexpr int ID = 16;
    static constexpr bool PERM = false, AFTER_DRAIN = false;
    float* ya; float* yb; const bf16_t* pp; const float* ssp; bf16_t* hb; const float* ng; float* ssn;
    __device__ __forceinline__ void operator()(const f32x4 (&acc)[2][2][4][2], const Unit& u, int wr, int wc, int fr, int fq) const {
        const int lane = fr + 16 * fq; (void)lane;
        const unsigned row0 = u.pm * BM + wr * 64 + fr, col0 = u.pn * BM + wc * 32 + 4 * fq;
        const bool smp = (u.pm * BM) >= MP;
        float* ybase = smp ? yb - (size_t)MP * DM : ya;
#pragma unroll
        for (int ai = 0; ai < 2; ++ai)
#pragma unroll
            for (int m = 0; m < 4; ++m) {
                const unsigned row = row0 + ai * HALF + m * 16; const unsigned ro = row * DM + col0;
                const float r = rsqrtf(ssp[row] * (1.0f / 1024.0f) + EPSN);
                float s = 0.f;
#pragma unroll
                for (int bj = 0; bj < 2; ++bj) {
#pragma unroll
                    for (int n = 0; n < 2; ++n) {
                        const unsigned cc = bj * HALF + n * 16;
                        const u32x2 pw = *(const u32x2*)(pp + ro + cc);
                        const f32x4 a = acc[ai][bj][m][n] * r;
                        f32x4 v = *(const f32x4*)(ybase + ro + cc);
                        v[0] += sigmoidf_(a[0]) * bflo(pw.x); v[1] += sigmoidf_(a[1]) * bfhi(pw.x); v[2] += sigmoidf_(a[2]) * bflo(pw.y); v[3] += sigmoidf_(a[3]) * bfhi(pw.y);
                        *(f32x4*)(ybase + ro + cc) = v;
                        if (hb) { s += (v[0] * v[0] + v[1] * v[1]) + (v[2] * v[2] + v[3] * v[3]); const f32x4 q = v * *(const f32x4*)(ng + col0 + cc);
                            u32x2 w; w.x = cvt_pk_bf16(q[0], q[1]); w.y = cvt_pk_bf16(q[2], q[3]); *(u32x2*)(hb + ro + cc) = w; }
                    }
                    MEMFENCE();
                }
                if (hb) { s = wsum4(s, lane); if (fq == 0) atomicAdd(ssn + row, s); }
            }
    }
};

__device__ __forceinline__ void transpose_job(int wv, const float* src, bf16_t* dst, int K, int Nsrc, int Ndst, bool win_map, float* tile  ) {
    const int tid = otid(wv); const int ntk = K / 64, ntn = Ndst / 64, nt = ntk * ntn;
    for (int t = blockIdx.x; t < nt; t += gridDim.x) {
        const int kt = t % ntk, ntile = t / ntk, k0 = kt * 64, n0 = ntile * 64;
        int srcc = n0, valid = 64;
        if (win_map) { if (n0 < 4608) srcc = n0; else if (n0 < 8704) srcc = n0 + 16; else if (n0 == 8704) { srcc = 4608; valid = 16; } else { srcc = 0; valid = 0; } }
        __syncthreads();
        { const int j = tid & 63, i0 = tid >> 6;
#pragma unroll
          for (int ii = 0; ii < 8; ++ii) { const int i = i0 + 8 * ii; tile[i * 65 + j] = (j < valid) ? src[(size_t)(k0 + i) * Nsrc + srcc + j] : 0.f; } }
        __syncthreads();
        { const int i = tid & 63, j0 = tid >> 6;
#pragma unroll
          for (int jj = 0; jj < 8; ++jj) { const int j = j0 + 8 * jj; dst[(size_t)(n0 + j) * K + k0 + i] = f2bf(tile[i * 65 + j]); } }
    }
}
__device__ __forceinline__ void phase_weights(int wv, const Params& P, unsigned char* lds) {
    float* tile = (float*)lds;
    for (int l = 0; l < 2; ++l) {
        transpose_job(wv, P.in[I_WIN] + (size_t)l * 1024 * 8720, (bf16_t*)(P.ws + WS_WIN) + (size_t)l * NWIN * 1024, 1024, 8720, NWIN, true, tile);
        transpose_job(wv, P.in[I_WOA] + (size_t)l * 512 * 1024, (bf16_t*)(P.ws + WS_WOA) + (size_t)l * 1024 * 512, 512, 1024, 1024, false, tile);
        transpose_job(wv, P.in[I_WOB] + (size_t)l * 1024 * 1024, (bf16_t*)(P.ws + WS_WOB) + (size_t)l * 1024 * 1024, 1024, 1024, 1024, false, tile);
        transpose_job(wv, P.in[I_WOC] + (size_t)l * 512 * 1024, (bf16_t*)(P.ws + WS_WOC) + (size_t)l * 1024 * 512, 512, 1024, 1024, false, tile);
        transpose_job(wv, P.in[I_WOUT] + (size_t)l * 1024 * 1024, (bf16_t*)(P.ws + WS_WOUT) + (size_t)l * 1024 * 1024, 1024, 1024, 1024, false, tile);
        transpose_job(wv, P.in[I_WPG] + (size_t)l * 1024 * 1024, (bf16_t*)(P.ws + WS_WPG) + (size_t)l * 1024 * 1024, 1024, 1024, 1024, false, tile);
        transpose_job(wv, P.in[I_WPP] + (size_t)l * 256 * 1024, (bf16_t*)(P.ws + WS_WPP) + (size_t)l * 1024 * 256, 256, 1024, 1024, false, tile);
    }
    const size_t gt = (size_t)blockIdx.x * 512 + otid(wv), gs = (size_t)gridDim.x * 512;
    { const size_t n4 = (size_t)2 * 8 * 512 * 512 / 4; const f32x4* ck = (const f32x4*)P.in[I_CK]; const f32x4* cv = (const f32x4*)P.in[I_CV]; u32x2* dk = (u32x2*)(P.ws + WS_KC); u32x2* dv = (u32x2*)(P.ws + WS_VC);
      for (size_t i = gt; i < n4; i += gs) { const f32x4 a = ck[i], b = cv[i]; u32x2 w; w.x = cvt_pk_bf16(a[0], a[1]); w.y = cvt_pk_bf16(a[2], a[3]); dk[i] = w; w.x = cvt_pk_bf16(b[0], b[1]); w.y = cvt_pk_bf16(b[2], b[3]); dv[i] = w; } }
    { float* ss = (float*)(P.ws + WS_SS); const size_t n = (size_t)NG * 4 * MLOC; for (size_t i = gt; i < n; i += gs) ss[i] = 0.f;
      if (gt < 256) ((unsigned*)(P.ws + WS_CTR))[gt] = 0u; }
}

__device__ __forceinline__ void phase_prep(int wv, const Params& P, int g) {
    const int M = (g == 0) ? MLOC : MP; const int tid = otid(wv); const int w = tid >> 6, lane = tid & 63;
    bf16_t* hb = (bf16_t*)(P.ws + WS_HBUF); float* ss = (float*)(P.ws + WS_SS) + (size_t)(g * 4 + 0) * MLOC; bf16_t* pb = (bf16_t*)(P.ws + WS_PBUF);
    const float* ng = P.in[I_NG];
    f32x4 gv[4];
#pragma unroll
    for (int k = 0; k < 4; ++k) gv[k] = *(const f32x4*)(ng + k * 256 + lane * 4);
    for (int row = blockIdx.x * 8 + w; row < M; row += gridDim.x * 8) {
        const float* xr = x_row(P, g, row); float s = 0.f;
#pragma unroll
        for (int k = 0; k < 4; ++k) { const f32x4 v = *(const f32x4*)(xr + k * 256 + lane * 4); s += (v[0] * v[0] + v[1] * v[1]) + (v[2] * v[2] + v[3] * v[3]);
            const f32x4 q = v * gv[k]; u32x2 o; o.x = cvt_pk_bf16(q[0], q[1]); o.y = cvt_pk_bf16(q[2], q[3]); *(u32x2*)(hb + (size_t)row * DM + k * 256 + lane * 4) = o; }
#pragma unroll
        for (int o = 32; o >= 1; o >>= 1) s += bperm(s, lane ^ o);
        if (lane == 0) ss[row] = s;
#pragma unroll
        for (int l = 0; l < 2; ++l) {
            const float* pr = row < MP ? P.in[I_PP] + (((size_t)l * NB * SEQ) + (size_t)g * MP + row) * 256 : P.in[I_PS] + (((size_t)l * MSMP) + (row - MP)) * 256;
            const f32x4 v = *(const f32x4*)(pr + lane * 4); u32x2 o; o.x = cvt_pk_bf16(v[0], v[1]); o.y = cvt_pk_bf16(v[2], v[3]);
            *(u32x2*)(pb + ((size_t)l * MLOC + row) * 256 + lane * 4) = o;
        }
    }
}

__device__ __forceinline__ void attn_item(int wv, const Params& P, int g, int l, int item, bool sample, unsigned char* lds) {
    const int tid = otid(wv), w = tid >> 6, lane = tid & 63, fr = lane & 15, fq = lane >> 4, h = w;
    bf16_t* vt = (bf16_t*)(lds + w * 19712);
    bf16_t* qs = (bf16_t*)(lds + w * 19712 + 9216);
    float* btab = (float*)(lds + w * 19712 + 18432);
    const float* rb = P.in[I_RB] + (size_t)(l * 8 + h) * 257;
    for (int i = lane; i < 257; i += 64) btab[i] = rb[i];
    const float bconst = rb[256];
    const bf16_t* proj = (const bf16_t*)(P.ws + WS_PROJ);
    int qrow0, nq, ntile, bl = 0, c = 0, sb = 0;
    if (!sample) { bl = item >> 6; c = item & 63; qrow0 = bl * SEQ + c * 64; nq = 64; ntile = (c < 8 ? c : 8) + 1; }
    else { sb = item; qrow0 = MP + sb * SL; nq = SL; ntile = 9; }
    float gq[2][8];
#pragma unroll
    for (int ks = 0; ks < 2; ++ks)
#pragma unroll
        for (int e = 0; e < 8; ++e) gq[ks][e] = P.in[I_QN][l * 64 + 32 * ks + 8 * fq + e] * 0.125f;
    const float* gkp = P.in[I_KN] + l * 64 + 8 * fq;
#pragma unroll
    for (int qt = 0; qt < 4; ++qt) {
        int qi = 16 * qt + fr; if (qi > nq - 1) qi = nq - 1;
        const bf16_t* qp = proj + (size_t)(qrow0 + qi) * NPROJ + C_Q + h * 64 + 8 * fq;
        float f0[8], f1[8]; unpack8(*(const u32x4*)qp, f0); unpack8(*(const u32x4*)(qp + 32), f1);
        float s = 0.f;
#pragma unroll
        for (int e = 0; e < 8; ++e) s += f0[e] * f0[e] + f1[e] * f1[e];
        s = wsum4(s, lane); const float r = rsqrtf(s * (1.0f / 64.0f) + EPSN);
#pragma unroll
        for (int e = 0; e < 8; ++e) { f0[e] *= r * gq[0][e]; f1[e] *= r * gq[1][e]; }
        *(u32x4*)(qs + (16 * qt + fr) * 72 + 8 * fq) = pack8(f0); *(u32x4*)(qs + (16 * qt + fr) * 72 + 32 + 8 * fq) = pack8(f1);
    }
    float mrun[4], lrun[4]; f32x4 o[4][4];
#pragma unroll
    for (int qt = 0; qt < 4; ++qt) { mrun[qt] = -1e30f; lrun[qt] = 0.f;
#pragma unroll
        for (int dt = 0; dt < 4; ++dt) o[dt][qt] = (f32x4){0.f, 0.f, 0.f, 0.f}; }
    LDSWAIT();
    for (int ti = 0; ti < ntile; ++ti) {
        const bf16_t* kp; const bf16_t* vp; int stride, donorm, relbase, nvalid; float* ko = nullptr; float* vo = nullptr;
        if (!sample) { const int j = ntile - 1 - ti, kc = c - j; const size_t r0 = (size_t)(bl * SEQ + kc * 64);
            kp = proj + r0 * NPROJ + C_K + h * 64; vp = proj + r0 * NPROJ + C_V + h * 64; stride = NPROJ; donorm = 1; relbase = 64 * j; nvalid = 64;
            if (j == 0 && c >= 56) { const size_t orow = ((size_t)(l * NB + g * GB + bl) * 512 + (c - 56) * 64) * 512 + h * 64; ko = P.out + O_PK + orow; vo = P.out + O_PV + orow; } }
        else if (ti < 8) { const size_t r0 = ((size_t)(l * NSB + sb) * 512 + ti * 64) * 512 + h * 64;
            kp = (const bf16_t*)(P.ws + WS_KC) + r0; vp = (const bf16_t*)(P.ws + WS_VC) + r0; stride = 512; donorm = 0; relbase = 512 - 64 * ti; nvalid = 64; }
        else { const size_t r0 = (size_t)(MP + sb * SL);
            kp = proj + r0 * NPROJ + C_K + h * 64; vp = proj + r0 * NPROJ + C_V + h * 64; stride = NPROJ; donorm = 1; relbase = 0; nvalid = SL;
            const size_t orow = ((size_t)(l * NSB + sb) * SL) * 512 + h * 64; ko = P.out + O_SK + orow; vo = P.out + O_SV + orow; }
        MEMFENCE();
        { const int i = lane & 31;
#pragma unroll
          for (int pp = 0; pp < 4; ++pp) {
              const int dg = (lane >> 5) + 2 * pp; int k0 = 2 * i, k1 = 2 * i + 1; const bool ok0 = k0 < nvalid, ok1 = k1 < nvalid; if (!ok0) k0 = nvalid - 1; if (!ok1) k1 = nvalid - 1;
              const u32x4 a = *(const u32x4*)(vp + (size_t)k0 * stride + 8 * dg), b = *(const u32x4*)(vp + (size_t)k1 * stride + 8 * dg);
              unsigned* dst = (unsigned*)(vt + (8 * dg) * 72 + 2 * i);
              dst[0 * 36] = (a.x & 0xffffu) | (b.x << 16); dst[1 * 36] = (a.x >> 16) | (b.x & 0xffff0000u);
              dst[2 * 36] = (a.y & 0xffffu) | (b.y << 16); dst[3 * 36] = (a.y >> 16) | (b.y & 0xffff0000u);
              dst[4 * 36] = (a.z & 0xffffu) | (b.z << 16); dst[5 * 36] = (a.z >> 16) | (b.z & 0xffff0000u);
              dst[6 * 36] = (a.w & 0xffffu) | (b.w << 16); dst[7 * 36] = (a.w >> 16) | (b.w & 0xffff0000u);
              if (vo) { float f[8];
                  if (ok0) { unpack8(a, f); float* d = vo + (size_t)k0 * 512 + 8 * dg; *(f32x4*)d = (f32x4){f[0], f[1], f[2], f[3]}; *(f32x4*)(d + 4) = (f32x4){f[4], f[5], f[6], f[7]}; }
                  if (ok1) { unpack8(b, f); float* d = vo + (size_t)k1 * 512 + 8 * dg; *(f32x4*)d = (f32x4){f[0], f[1], f[2], f[3]}; *(f32x4*)(d + 4) = (f32x4){f[4], f[5], f[6], f[7]}; } }
          } }
        bf16x8 kf[4][2];
        float gk[2][8];
        if (donorm) {
#pragma unroll
            for (int ks = 0; ks < 2; ++ks) { const f32x4 a = *(const f32x4*)(gkp + 32 * ks), b = *(const f32x4*)(gkp + 32 * ks + 4);
#pragma unroll
                for (int e = 0; e < 4; ++e) { gk[ks][e] = a[e]; gk[ks][4 + e] = b[e]; } }
        } else {
#pragma unroll
            for (int ks = 0; ks < 2; ++ks)
#pragma unroll
                for (int e = 0; e < 8; ++e) gk[ks][e] = 1.f;
        }
#pragma unroll
        for (int kt = 0; kt < 4; ++kt) {
            const int kk = 32 * (kt >> 1) + 8 * (fr >> 2) + 4 * (kt & 1) + (fr & 3); const bool okk = kk < nvalid; const int kl = okk ? kk : nvalid - 1;
            const bf16_t* kr = kp + (size_t)kl * stride + 8 * fq;
            const u32x4 r0 = *(const u32x4*)kr, r1 = *(const u32x4*)(kr + 32);
            if (donorm) {
                float f0[8], f1[8]; unpack8(r0, f0); unpack8(r1, f1);
                float s = 0.f;
#pragma unroll
                for (int e = 0; e < 8; ++e) s += f0[e] * f0[e] + f1[e] * f1[e];
                s = wsum4(s, lane); const float r = rsqrtf(s * (1.0f / 64.0f) + EPSN);
#pragma unroll
                for (int e = 0; e < 8; ++e) { f0[e] *= r * gk[0][e]; f1[e] *= r * gk[1][e]; }
                if (ko && okk) { float* d = ko + (size_t)kk * 512 + 8 * fq; *(f32x4*)d = (f32x4){f0[0], f0[1], f0[2], f0[3]}; *(f32x4*)(d + 4) = (f32x4){f0[4], f0[5], f0[6], f0[7]};
                    *(f32x4*)(d + 32) = (f32x4){f1[0], f1[1], f1[2], f1[3]}; *(f32x4*)(d + 36) = (f32x4){f1[4], f1[5], f1[6], f1[7]}; }
                kf[kt][0] = as_bf8(pack8(f0)); kf[kt][1] = as_bf8(pack8(f1));
            } else { kf[kt][0] = as_bf8(r0); kf[kt][1] = as_bf8(r1); }
        }
        const bool cbias = relbase >= 191;
        LDSWAIT();
#pragma unroll
        for (int qt = 0; qt < 4; ++qt) {
            f32x4 s[4];
            { const bf16x8 q0 = *(const bf16x8*)(qs + (16 * qt + fr) * 72 + 8 * fq), q1 = *(const bf16x8*)(qs + (16 * qt + fr) * 72 + 32 + 8 * fq);
#pragma unroll
              for (int kt = 0; kt < 4; ++kt) { s[kt] = MFMA16(kf[kt][0], q0, ((f32x4){0.f, 0.f, 0.f, 0.f})); s[kt] = MFMA16(kf[kt][1], q1, s[kt]); } }
            const int qi = 16 * qt + fr; float mx = -1e30f;
#pragma unroll
            for (int kt = 0; kt < 4; ++kt)
#pragma unroll
                for (int jj = 0; jj < 4; ++jj) {
                    const int kk = 32 * (kt >> 1) + 8 * fq + 4 * (kt & 1) + jj;
                    float bias;
                    if (cbias) bias = bconst; else { int rel = relbase + qi - kk; rel = rel < -128 ? -128 : (rel > 128 ? 128 : rel); bias = btab[rel + 128]; }
                    float v = s[kt][jj] + bias; if (kk >= nvalid) v = -1e30f;
                    s[kt][jj] = v; mx = fmaxf(mx, v);
                }
            mx = wmax4(mx, lane);
            const float mnew = fmaxf(mrun[qt], mx); const float alpha = __expf(mrun[qt] - mnew); mrun[qt] = mnew;
            float ps = 0.f;
#pragma unroll
            for (int kt = 0; kt < 4; ++kt)
#pragma unroll
                for (int jj = 0; jj < 4; ++jj) { const float p = __expf(s[kt][jj] - mnew); s[kt][jj] = p; ps += p; }
            lrun[qt] = lrun[qt] * alpha + ps;
            bf16x8 pf[2];
#pragma unroll
            for (int sl = 0; sl < 2; ++sl) { u32x4 pw; pw.x = cvt_pk_bf16(s[2 * sl][0], s[2 * sl][1]); pw.y = cvt_pk_bf16(s[2 * sl][2], s[2 * sl][3]);
                pw.z = cvt_pk_bf16(s[2 * sl + 1][0], s[2 * sl + 1][1]); pw.w = cvt_pk_bf16(s[2 * sl + 1][2], s[2 * sl + 1][3]); pf[sl] = as_bf8(pw); }
#pragma unroll
            for (int dt = 0; dt < 4; ++dt) {
                const bf16x8 v0 = *(const bf16x8*)(vt + (16 * dt + fr) * 72 + 8 * fq), v1 = *(const bf16x8*)(vt + (16 * dt + fr) * 72 + 32 + 8 * fq);
                o[dt][qt] *= alpha; o[dt][qt] = MFMA16(v0, pf[0], o[dt][qt]); o[dt][qt] = MFMA16(v1, pf[1], o[dt][qt]);
            }
        }
        LDSWAIT();
    }
    bf16_t* oa = (bf16_t*)(P.ws + WS_OA);
#pragma unroll
    for (int qt = 0; qt < 4; ++qt) {
        const int qi = 16 * qt + fr; const float inv = 1.0f / wsum4(lrun[qt], lane);
        if (qi < nq) {
            const size_t row = (size_t)(qrow0 + qi);
#pragma unroll
            for (int dt = 0; dt < 4; ++dt) {
                const int d = h * 64 + 16 * dt + 4 * fq;
                const u32x2 gw = *(const u32x2*)(proj + row * NPROJ + C_GA + d);
                const f32x4 v = o[dt][qt] * inv;
                u32x2 ow; ow.x = cvt_pk_bf16(v[0] * siluf_(bflo(gw.x)), v[1] * siluf_(bfhi(gw.x))); ow.y = cvt_pk_bf16(v[2] * siluf_(bflo(gw.y)), v[3] * siluf_(bfhi(gw.y)));
                *(u32x2*)(oa + row * 512 + d) = ow;
            }
        }
    }
}

constexpr int SX_ROW = 0, SX_T = 33792, SB_ROW = 70656, SB_T = 79872, SC_ROW = 89088, S_DT = 98304, S_CUM = 100352, S_SSP = 102400;
__device__ __forceinline__ void ssd_item(int wv, const Params& P, int g, int l, int item, bool sample, unsigned char* lds) {
    const int tid = otid(wv), w = tid >> 6, lane = tid & 63, fr = lane & 15, fq = lane >> 4, hh = w >> 1, ph = w & 1;
    const int gi = item & 3, bi = item >> 2;
    const int row0 = sample ? MP + bi * SL : bi * SEQ, L = sample ? SL : SEQ, nch = sample ? 1 : 64;
    const int head = 4 * gi + hh;
    const float a_h = -__expf(P.in[I_ALOG][l * 16 + head]), dtbias = P.in[I_DTB][l * 16 + head], dsk = P.in[I_DSK][l * 16 + head];
    const bf16_t* proj = (const bf16_t*)(P.ws + WS_PROJ); const float* dtbuf = (const float*)(P.ws + WS_DT); bf16_t* ob = (bf16_t*)(P.ws + WS_OB);
    bf16_t* Xrow = (bf16_t*)(lds + SX_ROW); bf16_t* Xt = (bf16_t*)(lds + SX_T); bf16_t* Brow = (bf16_t*)(lds + SB_ROW); bf16_t* Bt = (bf16_t*)(lds + SB_T); bf16_t* Crow = (bf16_t*)(lds + SC_ROW);
    float* dtl = (float*)(lds + S_DT) + w * 64; float* cuml = (float*)(lds + S_CUM) + w * 64; float* ssp = (float*)(lds + S_SSP);
    f32x4 hacc[4][2];
#pragma unroll
    for (int nt = 0; nt < 4; ++nt)
#pragma unroll
        for (int pl = 0; pl < 2; ++pl) {
            if (sample) hacc[nt][pl] = *(const f32x4*)(P.in[I_SSM] + (((size_t)(l * NSB + bi) * 16 + head) * 64 + 16 * (2 * ph + pl) + fr) * 64 + 16 * nt + 4 * fq);
            else hacc[nt][pl] = (f32x4){0.f, 0.f, 0.f, 0.f};
        }
    const float* gnp = P.in[I_SNG] + l * 1024 + 256 * gi + 64 * hh + 32 * ph + 4 * fq;
    const int cg8 = tid % 48, seg = tid / 48;
    int xch; if (cg8 < 32) xch = 256 * gi + 8 * cg8; else if (cg8 < 40) xch = 1024 + 64 * gi + 8 * (cg8 - 32); else xch = 1280 + 64 * gi + 8 * (cg8 - 40);
    for (int ch = 0; ch < nch; ++ch) {
        const int t0 = ch * 64;
        __syncthreads();
        if (tid < 384) {
            float cw[4][8], acc[8][8];
            { const float* cwp = P.in[I_CWB] + (size_t)l * 4 * 1536 + xch; const float* cbp = P.in[I_CBB] + l * 1536 + xch;
#pragma unroll
              for (int k = 0; k < 4; ++k) { const f32x4 a = *(const f32x4*)(cwp + k * 1536), b = *(const f32x4*)(cwp + k * 1536 + 4); cw[k][0] = a[0]; cw[k][1] = a[1]; cw[k][2] = a[2]; cw[k][3] = a[3]; cw[k][4] = b[0]; cw[k][5] = b[1]; cw[k][6] = b[2]; cw[k][7] = b[3]; }
              const f32x4 a = *(const f32x4*)cbp, b = *(const f32x4*)(cbp + 4);
#pragma unroll
              for (int tk = 0; tk < 8; ++tk) { acc[tk][0] = a[0]; acc[tk][1] = a[1]; acc[tk][2] = a[2]; acc[tk][3] = a[3]; acc[tk][4] = b[0]; acc[tk][5] = b[1]; acc[tk][6] = b[2]; acc[tk][7] = b[3]; } }
#pragma unroll
            for (int r = 0; r < 11; ++r) {
                const int t = t0 + 8 * seg - 3 + r; float xv[8];
                if (t < 0) {
                    if (sample) { const float* sp = P.in[I_SCB] + ((size_t)(l * NSB + bi) * 3 + (3 + t)) * 1536 + xch; const f32x4 a = *(const f32x4*)sp, b = *(const f32x4*)(sp + 4);
                        xv[0] = a[0]; xv[1] = a[1]; xv[2] = a[2]; xv[3] = a[3]; xv[4] = b[0]; xv[5] = b[1]; xv[6] = b[2]; xv[7] = b[3]; }
                    else {
#pragma unroll
                        for (int e = 0; e < 8; ++e) xv[e] = 0.f; }
                } else { const int tl = t < L ? t : L - 1; unpack8(*(const u32x4*)(proj + (size_t)(row0 + tl) * NPROJ + C_XBC + xch), xv); }
#pragma unroll
                for (int k = 0; k < 4; ++k) { const int tk = r - k; if (tk >= 0 && tk < 8) {
#pragma unroll
                    for (int e = 0; e < 8; ++e) acc[tk][e] += cw[k][e] * xv[e]; } }
            }
#pragma unroll
            for (int tk = 0; tk < 8; ++tk)
#pragma unroll
                for (int e = 0; e < 8; ++e) acc[tk][e] = siluf_(acc[tk][e]);
            bf16_t* rdst; int rstride; bf16_t* tdst = nullptr;
            if (cg8 < 32) { rdst = Xrow + 8 * cg8; rstride = 264; tdst = Xt + (8 * cg8) * 72; }
            else if (cg8 < 40) { rdst = Brow + 8 * (cg8 - 32); rstride = 72; tdst = Bt + (8 * (cg8 - 32)) * 72; }
            else { rdst = Crow + 8 * (cg8 - 40); rstride = 72; }
#pragma unroll
            for (int tk = 0; tk < 8; ++tk) *(u32x4*)(rdst + (8 * seg + tk) * rstride) = pack8(acc[tk]);
            if (tdst) {
#pragma unroll
                for (int e = 0; e < 8; ++e) { u32x4 tw; tw.x = cvt_pk_bf16(acc[0][e], acc[1][e]); tw.y = cvt_pk_bf16(acc[2][e], acc[3][e]); tw.z = cvt_pk_bf16(acc[4][e], acc[5][e]); tw.w = cvt_pk_bf16(acc[6][e], acc[7][e]);
                    *(u32x4*)(tdst + e * 72 + 8 * seg) = tw; }
            }
        }
        { const int t = t0 + lane; const int tl = t < L ? t : L - 1;
          float dtv = softplusf_(dtbuf[(size_t)(row0 + tl) * 16 + head] + dtbias); if (t >= L) dtv = 0.f;
          float cum = dtv * a_h;
#pragma unroll
          for (int off = 1; off < 64; off <<= 1) { const float v = bperm(cum, (lane - off) & 63); if (lane >= off) cum += v; }
          dtl[lane] = dtv; cuml[lane] = cum; }
        __syncthreads();
        const float clast = cuml[63];
        bf16x8 xtf[2][2];
#pragma unroll
        for (int pl = 0; pl < 2; ++pl)
#pragma unroll
            for (int s = 0; s < 2; ++s) xtf[pl][s] = *(const bf16x8*)(Xt + (64 * hh + 16 * (2 * ph + pl) + fr) * 72 + 32 * s + 8 * fq);
        bf16x8 hf[2][2];
#pragma unroll
        for (int s2 = 0; s2 < 2; ++s2)
#pragma unroll
            for (int pl = 0; pl < 2; ++pl) { u32x4 hw; hw.x = cvt_pk_bf16(hacc[2 * s2][pl][0], hacc[2 * s2][pl][1]); hw.y = cvt_pk_bf16(hacc[2 * s2][pl][2], hacc[2 * s2][pl][3]);
                hw.z = cvt_pk_bf16(hacc[2 * s2 + 1][pl][0], hacc[2 * s2 + 1][pl][1]); hw.w = cvt_pk_bf16(hacc[2 * s2 + 1][pl][2], hacc[2 * s2 + 1][pl][3]); hf[s2][pl] = as_bf8(hw); }
        f32x4 vv[2][4];
#pragma unroll
        for (int it = 0; it < 4; ++it) {
            const int i = 16 * it + fr; const float ci = cuml[i];
            u32x2 zr[2];
            { const int t = t0 + i; const int tl = t < L ? t : L - 1;
#pragma unroll
              for (int pl = 0; pl < 2; ++pl) zr[pl] = *(const u32x2*)(proj + (size_t)(row0 + tl) * NPROJ + C_Z + 256 * gi + 64 * hh + 16 * (2 * ph + pl) + 4 * fq); }
            const bf16x8 cf0 = *(const bf16x8*)(Crow + i * 72 + 8 * fq), cf1 = *(const bf16x8*)(Crow + i * 72 + 32 + 8 * fq);
            f32x4 ain[2] = {(f32x4){0.f, 0.f, 0.f, 0.f}, (f32x4){0.f, 0.f, 0.f, 0.f}};
#pragma unroll
            for (int s = 0; s < 2; ++s) {
                f32x4 cb[2];
#pragma unroll
                for (int t = 0; t < 2; ++t) { const int jrow = 32 * s + 8 * (fr >> 2) + 4 * t + (fr & 3);
                    const bf16x8 a0 = *(const bf16x8*)(Brow + jrow * 72 + 8 * fq), a1 = *(const bf16x8*)(Brow + jrow * 72 + 32 + 8 * fq);
                    cb[t] = MFMA16(a0, cf0, ((f32x4){0.f, 0.f, 0.f, 0.f})); cb[t] = MFMA16(a1, cf1, cb[t]); }
                float wv[8];
                { const f32x4 ca = *(const f32x4*)(cuml + 32 * s + 8 * fq), cb2 = *(const f32x4*)(cuml + 32 * s + 8 * fq + 4), da = *(const f32x4*)(dtl + 32 * s + 8 * fq), db = *(const f32x4*)(dtl + 32 * s + 8 * fq + 4);
#pragma unroll
                  for (int ii = 0; ii < 8; ++ii) { const int j = 32 * s + 8 * fq + ii; const float cbv = cb[ii >> 2][ii & 3]; const float cjv = ii < 4 ? ca[ii & 3] : cb2[ii & 3], djv = ii < 4 ? da[ii & 3] : db[ii & 3];
                      wv[ii] = (j <= i) ? cbv * __expf(ci - cjv) * djv : 0.f; } }
                const bf16x8 wf = as_bf8(pack8(wv));
#pragma unroll
                for (int pl = 0; pl < 2; ++pl) ain[pl] = MFMA16(xtf[pl][s], wf, ain[pl]);
            }
            f32x4 ast[2] = {(f32x4){0.f, 0.f, 0.f, 0.f}, (f32x4){0.f, 0.f, 0.f, 0.f}};
#pragma unroll
            for (int s2 = 0; s2 < 2; ++s2) { const u32x2 c0 = *(const u32x2*)(Crow + i * 72 + 32 * s2 + 4 * fq), c1 = *(const u32x2*)(Crow + i * 72 + 32 * s2 + 16 + 4 * fq);
                u32x4 cw4; cw4.x = c0.x; cw4.y = c0.y; cw4.z = c1.x; cw4.w = c1.y; const bf16x8 cf2 = as_bf8(cw4);
#pragma unroll
                for (int pl = 0; pl < 2; ++pl) ast[pl] = MFMA16(hf[s2][pl], cf2, ast[pl]); }
            const float ei = __expf(ci); float sq = 0.f;
#pragma unroll
            for (int pl = 0; pl < 2; ++pl) { const u32x2 xw = *(const u32x2*)(Xrow + i * 264 + 64 * hh + 16 * (2 * ph + pl) + 4 * fq);
                const float x0 = bflo(xw.x), x1 = bfhi(xw.x), x2 = bflo(xw.y), x3 = bfhi(xw.y); const u32x2 zw = zr[pl];
                f32x4 y; y[0] = (ain[pl][0] + ei * ast[pl][0] + dsk * x0) * siluf_(bflo(zw.x)); y[1] = (ain[pl][1] + ei * ast[pl][1] + dsk * x1) * siluf_(bfhi(zw.x));
                y[2] = (ain[pl][2] + ei * ast[pl][2] + dsk * x2) * siluf_(bflo(zw.y)); y[3] = (ain[pl][3] + ei * ast[pl][3] + dsk * x3) * siluf_(bfhi(zw.y));
                vv[pl][it] = y; sq += (y[0] * y[0] + y[1] * y[1]) + (y[2] * y[2] + y[3] * y[3]); }
            sq = wsum4(sq, lane); if (fq == 0) ssp[w * 64 + i] = sq;
        }
        { const float el = __expf(clast);
#pragma unroll
          for (int nt = 0; nt < 4; ++nt)
#pragma unroll
              for (int pl = 0; pl < 2; ++pl) hacc[nt][pl] *= el;
#pragma unroll
          for (int s = 0; s < 2; ++s) {
              float dl[8];
              { const f32x4 ca = *(const f32x4*)(cuml + 32 * s + 8 * fq), cb2 = *(const f32x4*)(cuml + 32 * s + 8 * fq + 4), da = *(const f32x4*)(dtl + 32 * s + 8 * fq), db = *(const f32x4*)(dtl + 32 * s + 8 * fq + 4);
#pragma unroll
                for (int ii = 0; ii < 4; ++ii) { dl[ii] = __expf(clast - ca[ii]) * da[ii]; dl[4 + ii] = __expf(clast - cb2[ii]) * db[ii]; } }
#pragma unroll
              for (int pl = 0; pl < 2; ++pl) { float xf[8]; union { bf16x8 b; u32x4 u; } cv; cv.b = xtf[pl][s]; unpack8(cv.u, xf);
#pragma unroll
                  for (int ii = 0; ii < 8; ++ii) xf[ii] *= dl[ii];
                  const bf16x8 xdf = as_bf8(pack8(xf));
#pragma unroll
                  for (int nt = 0; nt < 4; ++nt) { const bf16x8 btf = *(const bf16x8*)(Bt + (16 * nt + fr) * 72 + 32 * s + 8 * fq); hacc[nt][pl] = MFMA16(btf, xdf, hacc[nt][pl]); } }
          } }
        __syncthreads();
#pragma unroll
        for (int it = 0; it < 4; ++it) { const int i = 16 * it + fr; float tot = 0.f;
#pragma unroll
            for (int ww = 0; ww < 8; ++ww) tot += ssp[ww * 64 + i];
            const float r = rsqrtf(tot * (1.0f / 256.0f) + EPSN);
            if (t0 + i < L) {
#pragma unroll
                for (int pl = 0; pl < 2; ++pl) { const f32x4 q = vv[pl][it] * r * *(const f32x4*)(gnp + 16 * pl); u32x2 ow; ow.x = cvt_pk_bf16(q[0], q[1]); ow.y = cvt_pk_bf16(q[2], q[3]);
                    *(u32x2*)(ob + (size_t)(row0 + t0 + i) * 1024 + 256 * gi + 64 * hh + 16 * (2 * ph + pl) + 4 * fq) = ow; } }
        }
    }
    { const int tid2 = otid(wv), w2 = tid2 >> 6, lane2 = tid2 & 63, fr2 = lane2 & 15, fq2 = lane2 >> 4, hh2 = w2 >> 1, ph2 = w2 & 1, head2 = 4 * gi + hh2;
      float* so = sample ? P.out + O_SSS + ((size_t)(l * NSB + bi) * 16 + head2) * 4096 : P.out + O_PSS + ((size_t)(l * NB + g * GB + bi) * 16 + head2) * 4096;
#pragma unroll
      for (int nt = 0; nt < 4; ++nt)
#pragma unroll
          for (int pl = 0; pl < 2; ++pl) *(f32x4*)(so + (16 * (2 * ph2 + pl) + fr2) * 64 + 16 * nt + 4 * fq2) = hacc[nt][pl];
      float* co = sample ? P.out + O_SCB + (size_t)(l * NSB + bi) * 3 * 1536 : P.out + O_PCB + (size_t)(l * NB + g * GB + bi) * 3 * 1536;
      for (int idx = tid2; idx < 3 * 384; idx += 512) { const int r = idx / 384, ci = idx % 384;
          const int xc = ci < 256 ? 256 * gi + ci : (ci < 320 ? 1024 + 64 * gi + (ci - 256) : 1280 + 64 * gi + (ci - 320));
          co[r * 1536 + xc] = bf1(proj[(size_t)(row0 + L - 3 + r) * NPROJ + C_XBC + xc]); } }
}

constexpr int LX_C = 0, LX_F = 17408, LH_O = 51200;
__device__ __forceinline__ void lru_item(int wv, const Params& P, int g, int l, int item, bool sample, unsigned char* lds) {
    const int tid = otid(wv), w = tid >> 6, lane = tid & 63, fr = lane & 15, fq = lane >> 4;
    const int kp = item & 3, bi = item >> 2;
    const int row0 = sample ? MP + bi * SL : bi * SEQ, L = sample ? SL : SEQ, nch = sample ? 1 : 64;
    const int kb = 2 * kp + (w >> 2), ct = w & 3, c = 64 * kb + 16 * ct + fr, cl = c - 128 * kp;
    const bf16_t* proj = (const bf16_t*)(P.ws + WS_PROJ); bf16_t* oc = (bf16_t*)(P.ws + WS_OC);
    bf16_t* XC = (bf16_t*)(lds + LX_C); float* XCF = (float*)(lds + LX_F); float* HOUT = (float*)(lds + LH_O);
    bf16x8 wrf[2], wif[2];
#pragma unroll
    for (int ks = 0; ks < 2; ++ks) { float a[8], b[8];
#pragma unroll
        for (int e = 0; e < 8; ++e) { const size_t wi = ((size_t)(l * 8 + kb) * 64 + 32 * ks + 8 * fq + e) * 64 + 16 * ct + fr; a[e] = P.in[I_WRG][wi]; b[e] = P.in[I_WIG][wi]; }
        wrf[ks] = as_bf8(pack8(a)); wif[ks] = as_bf8(pack8(b)); }
    const float br = P.in[I_BRG][l * 512 + c], bi_ = P.in[I_BIG][l * 512 + c], sp = softplusf_(-P.in[I_LAM][l * 512 + c]);
    float hstate = sample ? P.in[I_SLR][(size_t)(l * NSB + bi) * 512 + c] : 0.f;
    const int cg8 = tid & 15, tp = tid >> 4, xch = 128 * kp + 8 * cg8;
    for (int ch = 0; ch < nch; ++ch) {
        const int t0 = ch * 64;
        {
            float cw[4][8], acc[2][8];
            const float* cwp = P.in[I_CWC] + (size_t)l * 4 * 512 + xch; const float* cbp = P.in[I_CBC] + l * 512 + xch;
#pragma unroll
            for (int k = 0; k < 4; ++k) { const f32x4 a = *(const f32x4*)(cwp + k * 512), b = *(const f32x4*)(cwp + k * 512 + 4); cw[k][0] = a[0]; cw[k][1] = a[1]; cw[k][2] = a[2]; cw[k][3] = a[3]; cw[k][4] = b[0]; cw[k][5] = b[1]; cw[k][6] = b[2]; cw[k][7] = b[3]; }
            { const f32x4 a = *(const f32x4*)cbp, b = *(const f32x4*)(cbp + 4);
#pragma unroll
              for (int tk = 0; tk < 2; ++tk) { acc[tk][0] = a[0]; acc[tk][1] = a[1]; acc[tk][2] = a[2]; acc[tk][3] = a[3]; acc[tk][4] = b[0]; acc[tk][5] = b[1]; acc[tk][6] = b[2]; acc[tk][7] = b[3]; } }
#pragma unroll
            for (int r = 0; r < 5; ++r) {
                const int t = t0 + 2 * tp - 3 + r; float xv[8];
                if (t < 0) {
                    if (sample) { const float* sp2 = P.in[I_SCC] + ((size_t)(l * NSB + bi) * 3 + (3 + t)) * 512 + xch; const f32x4 a = *(const f32x4*)sp2, b = *(const f32x4*)(sp2 + 4);
                        xv[0] = a[0]; xv[1] = a[1]; xv[2] = a[2]; xv[3] = a[3]; xv[4] = b[0]; xv[5] = b[1]; xv[6] = b[2]; xv[7] = b[3]; }
                    else {
#pragma unroll
                        for (int e = 0; e < 8; ++e) xv[e] = 0.f; }
                } else { const int tl = t < L ? t : L - 1; unpack8(*(const u32x4*)(proj + (size_t)(row0 + tl) * NPROJ + C_XC + xch), xv); }
#pragma unroll
                for (int k = 0; k < 4; ++k) { const int tk = r - k; if (tk >= 0 && tk < 2) {
#pragma unroll
                    for (int e = 0; e < 8; ++e) acc[tk][e] += cw[k][e] * xv[e]; } }
            }
#pragma unroll
            for (int tk = 0; tk < 2; ++tk) { const int tok = 2 * tp + tk;
                *(u32x4*)(XC + tok * 136 + 8 * cg8) = pack8(acc[tk]);
                *(f32x4*)(XCF + tok * 132 + 8 * cg8) = (f32x4){acc[tk][0], acc[tk][1], acc[tk][2], acc[tk][3]}; *(f32x4*)(XCF + tok * 132 + 8 * cg8 + 4) = (f32x4){acc[tk][4], acc[tk][5], acc[tk][6], acc[tk][7]}; }
        }
        __syncthreads();
#pragma unroll
        for (int tt = 0; tt < 4; ++tt) {
            const bf16x8 a0 = *(const bf16x8*)(XC + (16 * tt + fr) * 136 + 64 * (w >> 2) + 8 * fq), a1 = *(const bf16x8*)(XC + (16 * tt + fr) * 136 + 64 * (w >> 2) + 32 + 8 * fq);
            f32x4 ar = MFMA16(a0, wrf[0], ((f32x4){0.f, 0.f, 0.f, 0.f})); ar = MFMA16(a1, wrf[1], ar);
            f32x4 ai = MFMA16(a0, wif[0], ((f32x4){0.f, 0.f, 0.f, 0.f})); ai = MFMA16(a1, wif[1], ai);
            float as_[4], bs_[4]; float A = 1.f, B = 0.f;
#pragma unroll
            for (int jj = 0; jj < 4; ++jj) { const int tok = 16 * tt + 4 * fq + jj; const float xf = XCF[tok * 132 + cl];
                const float r = sigmoidf_(ar[jj] + br), ig = sigmoidf_(ai[jj] + bi_); const float la = -8.0f * r * sp; float a = __expf(la); const float x2 = 2.0f * la; float mult = sqrtf(x2 > -0.05f ? -x2 * (1.0f + x2 * (0.5f + x2 * 0.16666667f)) : 1.0f - __expf(x2));
                if (!sample && t0 + tok == 0) mult = 1.0f;
                float bt = mult * ig * xf; if (t0 + tok >= L) { a = 1.f; bt = 0.f; }
                B = a * B + bt; A = A * a; as_[jj] = A; bs_[jj] = B; }
            float carry = hstate, mycarry = 0.f;
#pragma unroll
            for (int k = 0; k < 4; ++k) { const float Ak = bperm(A, fr + 16 * k), Bk = bperm(B, fr + 16 * k); if (k == fq) mycarry = carry; carry = Ak * carry + Bk; }
            hstate = carry;
#pragma unroll
            for (int jj = 0; jj < 4; ++jj) HOUT[(16 * tt + 4 * fq + jj) * 132 + cl] = bs_[jj] + as_[jj] * mycarry;
        }
        __syncthreads();
#pragma unroll
        for (int tk = 0; tk < 2; ++tk) { const int tok = 2 * tp + tk, t = t0 + tok;
            if (t < L) { const f32x4 h0 = *(const f32x4*)(HOUT + tok * 132 + 8 * cg8), h1 = *(const f32x4*)(HOUT + tok * 132 + 8 * cg8 + 4);
                float gf[8]; unpack8(*(const u32x4*)(proj + (size_t)(row0 + t) * NPROJ + C_GC + xch), gf);
                u32x4 ow; ow.x = cvt_pk_bf16(h0[0] * siluf_(gf[0]), h0[1] * siluf_(gf[1])); ow.y = cvt_pk_bf16(h0[2] * siluf_(gf[2]), h0[3] * siluf_(gf[3]));
                ow.z = cvt_pk_bf16(h1[0] * siluf_(gf[4]), h1[1] * siluf_(gf[5])); ow.w = cvt_pk_bf16(h1[2] * siluf_(gf[6]), h1[3] * siluf_(gf[7]));
                *(u32x4*)(oc + (size_t)(row0 + t) * 512 + xch) = ow; } }
    }
    { float* lo = sample ? P.out + O_SLR + (size_t)(l * NSB + bi) * 512 : P.out + O_PLR + (size_t)(l * NB + g * GB + bi) * 512;
      if (fq == 0) lo[c] = hstate;
      float* co = sample ? P.out + O_SCC + (size_t)(l * NSB + bi) * 3 * 512 : P.out + O_PCC + (size_t)(l * NB + g * GB + bi) * 3 * 512;
      if (tid < 384) { const int r = tid >> 7, ci = tid & 127; co[r * 512 + 128 * kp + ci] = bf1(proj[(size_t)(row0 + L - 3 + r) * NPROJ + C_XC + 128 * kp + ci]); } }
    __syncthreads();
}

__device__ __forceinline__ void phase_mixers(int wv, const Params& P, int g, int l, unsigned char* lds) {
    unsigned* ctr = (unsigned*)(P.ws + WS_CTR) + (g * 2 + l) * 16;
    int* slot = (int*)(lds + 163776);
    const int n_ssd = GB * 4, n_lru = GB * 4, n_smp = (g == 0) ? (32 + 32 + 8) : 0, n_att = GB * 64;
    const int total = n_ssd + n_lru + n_smp + n_att;
    for (;;) {
        __syncthreads();
        if (otid(wv) == 0) *slot = (int)atomicAdd(ctr, 1u);
        __syncthreads();
        int it = *slot;
        if (it >= total) break;
        #ifndef NO_SSD
        if (it < n_ssd) { ssd_item(wv, P, g, l, it, false, lds); continue; }
#endif
        it -= n_ssd;
        #ifndef NO_LRU
        if (it < n_lru) { lru_item(wv, P, g, l, it, false, lds); continue; }
#endif
        it -= n_lru;
        if (g == 0) {
#ifndef NO_SSD
            if (it < 32) { ssd_item(wv, P, g, l, it, true, lds); continue; }
#endif
            it -= 32;
#ifndef NO_LRU
            if (it < 32) { lru_item(wv, P, g, l, it, true, lds); continue; }
#endif
            it -= 32;
#ifndef NO_ATT
            if (it < 8) { attn_item(wv, P, g, l, it, true, lds); continue; }
#endif
            it -= 8;
        }
#ifndef NO_ATT
        attn_item(wv, P, g, l, it, false, lds);
#endif
    }
}

__global__ void __launch_bounds__(512) fwd_megakernel(Params Parg) {
    extern __shared__ __attribute__((aligned(16))) unsigned char shm[];
    cg::grid_group grid = cg::this_grid();
    PG8_LAS unsigned char* glds = (PG8_LAS unsigned char*)shm;
    const int G = (int)gridDim.x, cidx = (int)blockIdx.x; const int wv = __builtin_amdgcn_readfirstlane((int)(threadIdx.x >> 6));
    { const Params P = load_params(); phase_weights(wv, P, shm); }
    grid.sync();
#pragma unroll 1
    for (int g = 0; g < NG; ++g) {
        const int M = (g == 0) ? MLOC : MP;
        { const Params P = load_params(); phase_prep(wv, P, g); }
        grid.sync();
#pragma unroll 1
        for (int l = 0; l < 2; ++l) {
            {
                const Params P = load_params(); float* ssn = (float*)(P.ws + WS_SS) + (size_t)(g * 4 + l * 2 + 0) * MLOC; bf16_t* proj = (bf16_t*)(P.ws + WS_PROJ);
                Gemm gm{(const bf16_t*)(P.ws + WS_HBUF), (const bf16_t*)(P.ws + WS_WIN) + (size_t)l * NWIN * 1024, M, NWIN, 1024, wv};
                StaticOrder S; S.init(M, NWIN, G, cidx);
                EpiIn E{proj, (float*)(P.ws + WS_DT), ssn};
                GEMMCALL<EpiIn, StaticOrder, false>(glds, gm, S, E, nullptr);
            }
            grid.sync();
            { const Params P = load_params(); phase_mixers(wv, P, g, l, shm); }
            grid.sync();
            {
                const Params P = load_params(); bf16_t* proj = (bf16_t*)(P.ws + WS_PROJ);
                StaticOrder S; S.init(M, 1024, G, cidx);
                { Gemm gm{(const bf16_t*)(P.ws + WS_OA), (const bf16_t*)(P.ws + WS_WOA) + (size_t)l * 1024 * 512, M, 1024, 512, wv};
                  EpiMerge<0> E{proj + C_GM, (float*)(P.ws + WS_MIXF), (bf16_t*)(P.ws + WS_MIXB)}; GEMMCALL<EpiMerge<0>, StaticOrder, false>(glds, gm, S, E, nullptr); }
                { Gemm gm{(const bf16_t*)(P.ws + WS_OB), (const bf16_t*)(P.ws + WS_WOB) + (size_t)l * 1024 * 1024, M, 1024, 1024, wv};
                  EpiMerge<1> E{proj + C_GM + 1024, (float*)(P.ws + WS_MIXF), (bf16_t*)(P.ws + WS_MIXB)}; GEMMCALL<EpiMerge<1>, StaticOrder, false>(glds, gm, S, E, nullptr); }
                { Gemm gm{(const bf16_t*)(P.ws + WS_OC), (const bf16_t*)(P.ws + WS_WOC) + (size_t)l * 1024 * 512, M, 1024, 512, wv};
                  EpiMerge<2> E{proj + C_GM + 2048, (float*)(P.ws + WS_MIXF), (bf16_t*)(P.ws + WS_MIXB)}; GEMMCALL<EpiMerge<2>, StaticOrder, false>(glds, gm, S, E, nullptr); }
                { Gemm gm{(const bf16_t*)(P.ws + WS_PBUF) + (size_t)l * MLOC * 256, (const bf16_t*)(P.ws + WS_WPP) + (size_t)l * 1024 * 256, M, 1024, 256, wv};
                  EpiPP E{(bf16_t*)(P.ws + WS_PP)}; GEMMCALL<EpiPP, StaticOrder, false>(glds, gm, S, E, nullptr); }
            }
            grid.sync();
            {
                const Params P = load_params(); float* ssp = (float*)(P.ws + WS_SS) + (size_t)(g * 4 + l * 2 + 1) * MLOC;
                StaticOrder S; S.init(M, 1024, G, cidx);
                Gemm gm{(const bf16_t*)(P.ws + WS_MIXB), (const bf16_t*)(P.ws + WS_WOUT) + (size_t)l * 1024 * 1024, M, 1024, 1024, wv};
                float* ya = P.out + O_YP + (size_t)g * MP * DM; float* yb = P.out + O_YS;
                const float* xa = (l == 0) ? P.in[I_XP] + (size_t)g * MP * DM : ya; const float* xb = (l == 0) ? P.in[I_XS] : yb;
                EpiOut E{xa, xb, ya, yb, (bf16_t*)(P.ws + WS_UBUF), P.in[I_PNG] + l * 1024, ssp};
                GEMMCALL<EpiOut, StaticOrder, false>(glds, gm, S, E, nullptr);
            }
            grid.sync();
            {
                const Params P = load_params(); float* ssp = (float*)(P.ws + WS_SS) + (size_t)(g * 4 + l * 2 + 1) * MLOC;
                StaticOrder S; S.init(M, 1024, G, cidx);
                Gemm gm{(const bf16_t*)(P.ws + WS_UBUF), (const bf16_t*)(P.ws + WS_WPG) + (size_t)l * 1024 * 1024, M, 1024, 1024, wv};
                float* ya = P.out + O_YP + (size_t)g * MP * DM; float* yb = P.out + O_YS;
                EpiGate E{ya, yb, (const bf16_t*)(P.ws + WS_PP), ssp, (l == 0) ? (bf16_t*)(P.ws + WS_HBUF) : nullptr, P.in[I_NG] + 1024, (float*)(P.ws + WS_SS) + (size_t)(g * 4 + 2) * MLOC};
                GEMMCALL<EpiGate, StaticOrder, false>(glds, gm, S, E, nullptr);
            }
            grid.sync();
        }
    }
}

constexpr int LDS_BYTES = 163840;

extern "C" void kernel_launch(void* const* d_in, const int* in_sizes, int n_in, void* d_out, int out_size, void* d_ws, size_t ws_size, hipStream_t stream) {
    static int grid_blocks = 0;
    if (grid_blocks == 0) {
        if (n_in != 35 || (size_t)out_size != O_END || ws_size < WS_END) { fprintf(stderr, "kernel_launch: unexpected shapes: n_in %d out %d ws %zu (need %zu)\n", n_in, out_size, ws_size, (size_t)WS_END); grid_blocks = -1; return; }
        int dev = 0, cus = 0, per_cu = 0;
        hipGetDevice(&dev); hipDeviceGetAttribute(&cus, hipDeviceAttributeMultiprocessorCount, dev);
        if (hipFuncSetAttribute((const void*)fwd_megakernel, hipFuncAttributeMaxDynamicSharedMemorySize, LDS_BYTES) != hipSuccess) { fprintf(stderr, "kernel_launch: hipFuncSetAttribute failed\n"); grid_blocks = -1; return; }
        if (hipOccupancyMaxActiveBlocksPerMultiprocessor(&per_cu, (const void*)fwd_megakernel, 512, LDS_BYTES) != hipSuccess || per_cu < 1) { fprintf(stderr, "kernel_launch: occupancy query gives %d\n", per_cu); per_cu = 1; }
        (void)hipGetLastError();
        grid_blocks = cus;
    }
    if (grid_blocks < 0) return;
    Params p{};
    for (int i = 0; i < 35; ++i) p.in[i] = (const float*)d_in[i];
    p.out = (float*)d_out; p.ws = (unsigned char*)d_ws;
    void* args[] = {&p};
    hipError_t e = hipLaunchCooperativeKernel((const void*)fwd_megakernel, dim3(grid_blocks), dim3(512), args, LDS_BYTES, stream);
    if (e != hipSuccess) fprintf(stderr, "cooperative launch failed: %s (grid %d)\n", hipGetErrorString(e), grid_blocks);
}
```

```cpp
#include <hip/hip_runtime.h>
#include <hip/hip_cooperative_groups.h>
#include <cstdio>
namespace cg = cooperative_groups;
namespace pg8 {
#define PG8_LAS __attribute__((address_space(3)))
typedef unsigned short bf16_t;
typedef short bf16x8 __attribute__((ext_vector_type(8)));
typedef float f32x4 __attribute__((ext_vector_type(4)));
typedef unsigned u32x4 __attribute__((ext_vector_type(4)));
constexpr int BM = 256, BK = 64, HALF = 128, HTB = HALF * BK * 2  , STAGE_BYTES = 8 * HTB, NXCD = 8, WGM = 8;

__host__ __device__ __forceinline__ int lds_byte(int r, int c) { const int st = (r >> 4) * 2 + (c >> 5), rr = r & 15, cc = c & 31, ob = rr * 64 + cc * 2; return st * 1024 + (ob ^ (((ob >> 9) & 1) << 5)); }
__host__ __device__ __forceinline__ void stage_rc(int b, int& R, int& C) { const int st = b / 1024, sb = b % 1024, swz = sb ^ (((sb >> 9) & 1) << 5); R = (st >> 1) * 16 + swz / 64; C = (st & 1) * 32 + (swz % 64) / 2; }
__host__ __device__ __forceinline__ int perm32(int rho) { const int n = rho >> 4, i = rho & 15; return 8 * (i >> 2) + 4 * n + (i & 3); }

struct Unit { int pm, pn; };
struct Gemm { const bf16_t* A; const bf16_t* Bt; int M, N, K, wv; };
struct StaticOrder {
    int nM, nN, nwg, G, c;
    __host__ __device__ void init(int M, int N, int G_, int c_) { nM = M / BM; nN = N / BM; nwg = nM * nN; G = G_; c = c_; }
    __host__ __device__ bool next(int i, Unit& u) const {
        const long L = (long)i * G + c; if (L >= nwg) return false;
        int wgid = (int)L; { const int q = nwg / NXCD, r = nwg % NXCD, xcd = wgid % NXCD, off = wgid / NXCD; wgid = (xcd < r ? xcd * (q + 1) : r * (q + 1) + (xcd - r) * q) + off; }
        const int nig = WGM * nN, gid = wgid / nig, fm = gid * WGM, gsz = (nM - fm) < WGM ? (nM - fm) : WGM;
        u.pm = fm + ((wgid % nig) % gsz); u.pn = (wgid % nig) / gsz; return true;
    }
    __device__ __forceinline__ void a_ready(const Unit&) const {}
    __device__ __forceinline__ void done(const Unit&) const {}
};
__device__ __forceinline__ unsigned cvt_pk_bf16(float lo, float hi) { unsigned r; asm volatile("v_cvt_pk_bf16_f32 %0, %1, %2" : "=v"(r) : "v"(lo), "v"(hi)); return r; }
template <class Epi, class Sched, bool STAMP = false>
__device__ __forceinline__ void gemm_phase(PG8_LAS unsigned char* lds, const Gemm g, const Sched& S, const Epi& E, unsigned long long* stamps) {
    int tid_; asm volatile("v_mbcnt_lo_u32_b32 %0, -1, 0\n\tv_mbcnt_hi_u32_b32 %0, -1, %0" : "=v"(tid_)); tid_ += g.wv * 64; const int tid = tid_, wid = __builtin_amdgcn_readfirstlane(tid >> 6), lane = tid & 63, wr = wid >> 2, wc = wid & 3, fr = lane & 15, fq = lane >> 4;
    const int K = g.K, nt = K / BK;
    int ts_lo = 0, ts_hi = 0, nts = 0; const unsigned long long rt_entry = STAMP ? (unsigned long long)wall_clock64() : 0ull;
#define PG8_STAMP() do { if (STAMP && wid == 0 && nts < 64) { const unsigned long long _c = (unsigned long long)clock64(); \
        ts_lo = (lane == nts) ? (int)(unsigned)_c : ts_lo; ts_hi = (lane == nts) ? (int)(unsigned)(_c >> 32) : ts_hi; ++nts; } } while (0)
    PG8_STAMP();
    unsigned voffA[2], voffB[2];
#pragma unroll
    for (int i = 0; i < 2; ++i) { int R, C; stage_rc(tid * 16 + i * 8192, R, C); const int Rb = Epi::PERM ? ((R & ~31) + perm32(R & 31)) : R;
        voffA[i] = (unsigned)(R * K + C) * 2u; voffB[i] = (unsigned)(Rb * K + C) * 2u; }
    const size_t kstep = (size_t)(BK * 2);
    const size_t hstep = (size_t)HALF * K * 2;
    const size_t tstep = 2 * hstep;
    const unsigned ldsw = (unsigned)wid * 1024u;
    const int aoff = lds_byte(wr * 64 + fr, fq * 8), boff = lds_byte(wc * 32 + fr, fq * 8);
#define PG8_SA(b, h) (((b) * 2 + (h)) * HTB)
#define PG8_SB(b, h) ((4 + (b) * 2 + (h)) * HTB)
#define PG8_STAGE(bufoff, gbase, voff) do { _Pragma("unroll") for (int _i = 0; _i < 2; ++_i) \
        __builtin_amdgcn_global_load_lds((const unsigned*)((const char*)(gbase) + (voff)[_i]), (PG8_LAS unsigned*)(lds + (bufoff) + ldsw + _i * 8192), 16, 0, 0); } while (0)
#define PG8_LDA(dst, b, h) do { _Pragma("unroll") for (int m = 0; m < 4; ++m) _Pragma("unroll") for (int k = 0; k < 2; ++k) dst[m][k] = *(const PG8_LAS bf16x8*)(lds + PG8_SA(b, h) + aoff + m * 2048 + k * 1024); } while (0)
#define PG8_LDB(dst, b, h) do { _Pragma("unroll") for (int n = 0; n < 2; ++n) _Pragma("unroll") for (int k = 0; k < 2; ++k) dst[n][k] = *(const PG8_LAS bf16x8*)(lds + PG8_SB(b, h) + boff + n * 2048 + k * 1024); } while (0)
#define PG8_MMA(ai, bj, At, Bt) do { __builtin_amdgcn_s_setprio(1); _Pragma("unroll") for (int m = 0; m < 4; ++m) _Pragma("unroll") for (int n = 0; n < 2; ++n) _Pragma("unroll") for (int k = 0; k < 2; ++k) \
        acc[ai][bj][m][n] = __builtin_amdgcn_mfma_f32_16x16x32_bf16(Bt[n][k], At[m][k], acc[ai][bj][m][n], 0, 0, 0); __builtin_amdgcn_s_setprio(0); } while (0)
#define PG8_WAIT_V(n) asm volatile("s_waitcnt vmcnt(" #n ")" ::: "memory")
#define PG8_WAIT_L(n) asm volatile("s_waitcnt lgkmcnt(" #n ")" ::: "memory")
#define PG8_BAR __builtin_amdgcn_s_barrier()
#define PG8_SCHED __builtin_amdgcn_sched_barrier(0)
    Unit cur, nxt; int ui = 0;
    if (!S.next(0, cur)) return;
    f32x4 acc[2][2][4][2];
#pragma unroll
    for (int a = 0; a < 2; ++a)
#pragma unroll
        for (int b = 0; b < 2; ++b)
#pragma unroll
            for (int m = 0; m < 4; ++m)
#pragma unroll
                for (int n = 0; n < 2; ++n) acc[a][b][m][n] = (f32x4){0.f, 0.f, 0.f, 0.f};
    bf16x8 At[4][2], B0[2][2], B1[2][2];
    const char* cA = (const char*)g.A + (size_t)cur.pm * tstep; const char* cB = (const char*)g.Bt + (size_t)cur.pn * tstep;
    S.a_ready(cur);
    PG8_STAGE(PG8_SB(0, 0), cB, voffB); PG8_STAGE(PG8_SA(0, 0), cA, voffA); PG8_STAGE(PG8_SB(0, 1), cB + hstep, voffB); PG8_STAGE(PG8_SA(0, 1), cA + hstep, voffA);
    if (wr == 1) PG8_BAR;
    PG8_WAIT_V(4); PG8_BAR;
    PG8_STAGE(PG8_SB(1, 0), cB + kstep, voffB); PG8_STAGE(PG8_SA(1, 0), cA + kstep, voffA); PG8_STAGE(PG8_SB(1, 1), cB + hstep + kstep, voffB);
    PG8_WAIT_V(6); PG8_BAR;
    PG8_STAMP();
    for (;;) {
        const bool has_next = S.next(ui + 1, nxt);
        const char* nA = has_next ? (const char*)g.A + (size_t)nxt.pm * tstep : cA; const char* nB = has_next ? (const char*)g.Bt + (size_t)nxt.pn * tstep : cB;
        for (int t = 0; t < nt; t += 2) {
            if constexpr (Epi::HAS_MID) { if (t == Epi::T1 || t == Epi::T2) E.mid(acc, cur, t, wr, wc, fr, fq); }
            const bool last = (t == nt - 2);
            const char* a1 = cA + (size_t)(t + 1) * kstep;
            const char* a2 = last ? nA : cA + (size_t)(t + 2) * kstep; const char* b2 = last ? nB : cB + (size_t)(t + 2) * kstep;
            const char* a3 = a2 + kstep; const char* b3 = b2 + kstep;
            if (last && has_next) S.a_ready(nxt);
            PG8_LDB(B0, 0, 0); PG8_SCHED; PG8_LDA(At, 0, 0); PG8_STAGE(PG8_SA(1, 1), a1 + hstep, voffA);
            PG8_WAIT_L(8); PG8_BAR; PG8_WAIT_L(0); PG8_MMA(0, 0, At, B0); PG8_BAR; PG8_SCHED;
            PG8_LDB(B1, 0, 1); PG8_STAGE(PG8_SB(0, 0), b2, voffB);
            PG8_BAR; PG8_WAIT_L(0); PG8_MMA(0, 1, At, B1); PG8_BAR;
            PG8_LDA(At, 0, 1); PG8_STAGE(PG8_SA(0, 0), a2, voffA);
            PG8_BAR; PG8_WAIT_L(0); PG8_MMA(1, 0, At, B0); PG8_BAR; PG8_SCHED;
            PG8_STAGE(PG8_SB(0, 1), b2 + hstep, voffB);
            PG8_WAIT_V(6); PG8_BAR; PG8_MMA(1, 1, At, B1); PG8_BAR;
            PG8_LDB(B0, 1, 0); PG8_SCHED; PG8_LDA(At, 1, 0); PG8_STAGE(PG8_SA(0, 1), a2 + hstep, voffA);
            PG8_WAIT_L(8); PG8_BAR; PG8_WAIT_L(0); PG8_MMA(0, 0, At, B0); PG8_BAR; PG8_SCHED;
            PG8_LDB(B1, 1, 1); PG8_STAGE(PG8_SB(1, 0), b3, voffB);
            PG8_BAR; PG8_WAIT_L(0); PG8_MMA(0, 1, At, B1); PG8_BAR;
            PG8_LDA(At, 1, 1); PG8_STAGE(PG8_SA(1, 0), a3, voffA);
            PG8_BAR; PG8_WAIT_L(0); PG8_MMA(1, 0, At, B0); PG8_BAR; PG8_SCHED;
            PG8_STAGE(PG8_SB(1, 1), b3 + hstep, voffB);
            PG8_WAIT_V(6); PG8_BAR; PG8_MMA(1, 1, At, B1); PG8_BAR;
        }
        PG8_STAMP();
        if constexpr (!Epi::AFTER_DRAIN) { E(acc, cur, wr, wc, fr, fq); S.done(cur); }
        PG8_STAMP();
        if (!has_next) break;
#pragma unroll
        for (int a = 0; a < 2; ++a)
#pragma unroll
            for (int b = 0; b < 2; ++b)
#pragma unroll
                for (int m = 0; m < 4; ++m)
#pragma unroll
                    for (int n = 0; n < 2; ++n) acc[a][b][m][n] = (f32x4){0.f, 0.f, 0.f, 0.f};
        cur = nxt; cA = nA; cB = nB; ++ui;
    }
    PG8_WAIT_V(0);
    if (wr == 0) PG8_BAR;
    PG8_BAR;
    if constexpr (Epi::AFTER_DRAIN) { E.fused(acc, cur, wr, wc, fr, fq, lds, wid, lane); S.done(cur); }
    PG8_STAMP();
    if (STAMP && wid == 0) { stamps[lane] = lane < nts ? (((unsigned long long)(unsigned)ts_hi << 32) | (unsigned)ts_lo) : 0ull;
        if (lane == 62) stamps[62] = rt_entry; if (lane == 63) stamps[63] = (unsigned long long)wall_clock64(); }
#undef PG8_STAMP
#undef PG8_SA
#undef PG8_SB
#undef PG8_STAGE
#undef PG8_LDA
#undef PG8_LDB
#undef PG8_MMA
#undef PG8_WAIT_V
#undef PG8_WAIT_L
#undef PG8_BAR
#undef PG8_SCHED
}
}
using namespace pg8;
#ifndef EPI_MASK
#define EPI_MASK 31
#endif
#define GEMMCALL gemm_sel
template <class Epi, class Sched, bool X> __device__ __forceinline__ void gemm_sel(PG8_LAS unsigned char* lds, const Gemm g, const Sched& S, const Epi& E, unsigned long long* st) { if constexpr ((EPI_MASK & Epi::ID) != 0) gemm_phase<Epi, Sched, X>(lds, g, S, E, st); }
typedef unsigned u32x2 __attribute__((ext_vector_type(2)));

constexpr int DM = 1024, SEQ = 4096, NB = 16, NSB = 8, SL = 32;
constexpr int GB = 4, NG = NB / GB;
constexpr int MP = GB * SEQ;
constexpr int MSMP = NSB * SL;
constexpr int MLOC = MP + MSMP;
constexpr int NPROJ = 8704;
constexpr int NWIN = 8960;
constexpr int C_Q = 0, C_K = 512, C_V = 1024, C_GA = 1536, C_Z = 2048, C_XBC = 3072, C_GC = 4608, C_XC = 5120, C_GM = 5632;
constexpr float EPSN = 1e-6f;

constexpr size_t al256(size_t x) { return (x + 255) & ~(size_t)255; }
constexpr size_t WS_WIN = 0;
constexpr size_t WS_WCAT = WS_WIN + al256((size_t)2 * NWIN * 1024 * 2);
constexpr size_t WS_WOUT = WS_WCAT + al256((size_t)2 * 1024 * 2048 * 2);
constexpr size_t WS_WPG = WS_WOUT + al256((size_t)2 * 1024 * 1024 * 2);
constexpr size_t WS_WPP = WS_WPG + al256((size_t)2 * 1024 * 1024 * 2);
constexpr size_t WS_KC = WS_WPP + al256((size_t)2 * 1024 * 256 * 2);
constexpr size_t WS_VC = WS_KC + al256((size_t)2 * 8 * 512 * 512 * 2);
constexpr size_t WS_SS = WS_VC + al256((size_t)2 * 8 * 512 * 512 * 2);
constexpr size_t WS_CTR = WS_SS + al256((size_t)NG * 4 * MLOC * 4);
constexpr size_t WS_HBUF = WS_CTR + 1024;
constexpr size_t WS_PROJ = WS_HBUF + al256((size_t)MLOC * 1024 * 2);
constexpr size_t WS_DT = WS_PROJ + al256((size_t)MLOC * NPROJ * 2);
constexpr size_t WS_OCAT = WS_DT + al256((size_t)MLOC * 16 * 4);
constexpr int OC_A = 0, OC_B = 512, OC_C = 1536, OCW = 2048;
constexpr size_t WS_MIXB = WS_OCAT + al256((size_t)MLOC * 2048 * 2);
constexpr size_t WS_UBUF = WS_MIXB + al256((size_t)MLOC * 1024 * 2);
constexpr size_t WS_PBUF = WS_UBUF + al256((size_t)MLOC * 1024 * 2);
constexpr size_t WS_PP = WS_PBUF + al256((size_t)2 * MLOC * 256 * 2);
constexpr size_t WS_SSDS = WS_PP + al256((size_t)MLOC * 1024 * 2);
constexpr size_t WS_ACB = WS_SSDS + al256((size_t)GB * 64 * 16 * 4096 * 4);
constexpr size_t WS_HZ = WS_ACB + al256((size_t)GB * 64 * 16 * 4);
constexpr size_t WS_PZ = WS_HZ + al256((size_t)MP * 512 * 4);
constexpr size_t WS_LCA = WS_PZ + al256((size_t)MP * 512 * 4);
constexpr size_t WS_LCB = WS_LCA + al256((size_t)GB * 64 * 512 * 4);
constexpr size_t WS_BAR = WS_LCB + al256((size_t)GB * 64 * 512 * 4);
constexpr size_t WS_XRES = WS_BAR + 16384;
constexpr size_t WS_XACT = WS_XRES + al256((size_t)MLOC * 1024 * 2);
constexpr size_t WS_LWF = WS_XACT + al256((size_t)GB * 64 * 4 * 64 * 384 * 2);
constexpr size_t WS_END = WS_LWF + 262144;

constexpr size_t O_YP = 0;
constexpr size_t O_YS = O_YP + (size_t)NB * SEQ * DM;
constexpr size_t O_PK = O_YS + (size_t)NSB * SL * DM;
constexpr size_t O_PV = O_PK + (size_t)2 * NB * 512 * 512;
constexpr size_t O_PCB = O_PV + (size_t)2 * NB * 512 * 512;
constexpr size_t O_PSS = O_PCB + (size_t)2 * NB * 3 * 1536;
constexpr size_t O_PCC = O_PSS + (size_t)2 * NB * 16 * 64 * 64;
constexpr size_t O_PLR = O_PCC + (size_t)2 * NB * 3 * 512;
constexpr size_t O_SK = O_PLR + (size_t)2 * NB * 512;
constexpr size_t O_SV = O_SK + (size_t)2 * NSB * SL * 512;
constexpr size_t O_SCB = O_SV + (size_t)2 * NSB * SL * 512;
constexpr size_t O_SSS = O_SCB + (size_t)2 * NSB * 3 * 1536;
constexpr size_t O_SCC = O_SSS + (size_t)2 * NSB * 16 * 64 * 64;
constexpr size_t O_SLR = O_SCC + (size_t)2 * NSB * 3 * 512;
constexpr size_t O_END = O_SLR + (size_t)2 * NSB * 512;

struct Params { const float* in[35]; float* out; unsigned char* ws; };
enum { I_XP = 0, I_XS, I_CK, I_CV, I_SCB, I_SSM, I_SCC, I_SLR, I_PP, I_PS, I_NG, I_WIN, I_QN, I_KN, I_RB, I_CWB, I_CBB, I_DTB, I_ALOG, I_DSK, I_SNG, I_CWC, I_CBC,
       I_WRG, I_BRG, I_WIG, I_BIG, I_LAM, I_WOA, I_WOB, I_WOC, I_WOUT, I_PNG, I_WPG, I_WPP };

#define KCONST __attribute__((address_space(4)))
__device__ __forceinline__ Params load_params() { auto p = __builtin_amdgcn_kernarg_segment_ptr(); asm volatile("" : "+s"(p)); Params r; const KCONST unsigned long long* q = (const KCONST unsigned long long*)p;
#pragma unroll
    for (int i = 0; i < 35; ++i) r.in[i] = (const float*)(const __attribute__((address_space(1))) float*)q[i];
    r.out = (float*)(__attribute__((address_space(1))) float*)q[35]; r.ws = (unsigned char*)(__attribute__((address_space(1))) unsigned char*)q[36]; return r; }
__device__ __forceinline__ int otid(int wv) { int t; asm volatile("v_mbcnt_lo_u32_b32 %0, -1, 0\n\tv_mbcnt_hi_u32_b32 %0, -1, %0" : "=v"(t)); return t + wv * 64; }
__device__ __forceinline__ float bflo(unsigned w) { return __uint_as_float(w << 16); }
__device__ __forceinline__ float bfhi(unsigned w) { return __uint_as_float(w & 0xffff0000u); }
__device__ __forceinline__ float bf1(bf16_t b) { return __uint_as_float(((unsigned)b) << 16); }
__device__ __forceinline__ bf16_t f2bf(float f) { return (bf16_t)(cvt_pk_bf16(f, 0.f) & 0xffffu); }
__device__ __forceinline__ float bperm(float v, int srclane) { return __int_as_float(__builtin_amdgcn_ds_bpermute(srclane << 2, __float_as_int(v))); }
__device__ __forceinline__ float wsum4(float v, int lane) { v += bperm(v, lane ^ 16); v += bperm(v, lane ^ 32); return v; }
__device__ __forceinline__ float wmax4(float v, int lane) { v = fmaxf(v, bperm(v, lane ^ 16)); v = fmaxf(v, bperm(v, lane ^ 32)); return v; }
__device__ __forceinline__ float sigmoidf_(float x) { return __builtin_amdgcn_rcpf(1.0f + __builtin_amdgcn_exp2f(x * -1.44269504f)); }
__device__ __forceinline__ float siluf_(float x) { return x * __builtin_amdgcn_rcpf(1.0f + __builtin_amdgcn_exp2f(x * -1.44269504f)); }
__device__ __forceinline__ float softplusf_(float x) { const float e = __expf(x); return x > 15.f ? x : (x < -5.f ? e * (1.0f - 0.5f * e) : __logf(1.0f + e)); }
__device__ __forceinline__ void unpack8(const u32x4 r, float (&f)[8]) { f[0] = bflo(r.x); f[1] = bfhi(r.x); f[2] = bflo(r.y); f[3] = bfhi(r.y); f[4] = bflo(r.z); f[5] = bfhi(r.z); f[6] = bflo(r.w); f[7] = bfhi(r.w); }
__device__ __forceinline__ u32x4 pack8(const float (&f)[8]) { u32x4 r; r.x = cvt_pk_bf16(f[0], f[1]); r.y = cvt_pk_bf16(f[2], f[3]); r.z = cvt_pk_bf16(f[4], f[5]); r.w = cvt_pk_bf16(f[6], f[7]); return r; }
__device__ __forceinline__ bf16x8 as_bf8(u32x4 r) { union { u32x4 u; bf16x8 b; } c; c.u = r; return c.b; }
#define MFMA16(a, b, c) __builtin_amdgcn_mfma_f32_16x16x32_bf16((a), (b), (c), 0, 0, 0)
#define MEMFENCE() asm volatile("" ::: "memory")
#define LDSWAIT() asm volatile("s_waitcnt lgkmcnt(0)" ::: "memory")

__device__ __forceinline__ const float* x_row(const Params& P, int g, int lr) { return lr < MP ? P.in[I_XP] + ((size_t)g * MP + lr) * DM : P.in[I_XS] + (size_t)(lr - MP) * DM; }
__device__ __forceinline__ float* y_row(const Params& P, int g, int lr) { return lr < MP ? P.out + O_YP + ((size_t)g * MP + lr) * DM : P.out + O_YS + (size_t)(lr - MP) * DM; }


#define XB_TMO      128
#define XB_XCNT(j)  (256  + 64 * (j))
#define XB_XSUB(j)  (1280 + 64 * (j))
#define XB_XGEN(j)  (2304 + 64 * (j))
#define XB_TOP      3328
#define XB_TOPGEN   3392
#define XCD_BAR_WORDS 3456
#define XB_SPIN_CAP (1u << 18)
__device__ __forceinline__ unsigned xb_ld(unsigned* p)              { return __hip_atomic_load(p, __ATOMIC_RELAXED, __HIP_MEMORY_SCOPE_AGENT); }
__device__ __forceinline__ unsigned xb_add(unsigned* p, unsigned v) { return __hip_atomic_fetch_add(p, v, __ATOMIC_RELAXED, __HIP_MEMORY_SCOPE_AGENT); }
__device__ __forceinline__ unsigned xb_xcc_id() { return (unsigned)__builtin_amdgcn_s_getreg((3 << 11) | 20) & 0xFu; }
#define XB_SPIN(cond, bar) do { unsigned _sp = 0; while (cond) { __builtin_amdgcn_s_sleep(1); \
    if ((++_sp & 255u) == 0u) { if (xb_ld(&(bar)[XB_TMO])) break; if (_sp > XB_SPIN_CAP) { atomicAdd(&(bar)[XB_TMO], 1u); break; } } } } while (0)
__device__ __forceinline__ void xcd_barrier_complete(unsigned* bar, unsigned x, unsigned& nloc, unsigned& nx) {
    const unsigned G = gridDim.x;
    unsigned sum, cnt, mine, sp = 0u;
    for (;;) {
        sum = 0u; cnt = 0u; mine = 0u;
#pragma unroll
        for (unsigned j = 0; j < 16; ++j) { const unsigned c = xb_ld(&bar[XB_XCNT(j)]); sum += c; cnt += (c > 0u) ? 1u : 0u; mine = (j == x) ? c : mine; }
        if (sum == G) break;
        __builtin_amdgcn_s_sleep(1);
        if ((++sp & 255u) == 0u) { if (xb_ld(&bar[XB_TMO])) break; if (sp > XB_SPIN_CAP) { atomicAdd(&bar[XB_TMO], 1u); break; } }
    }
    nloc = mine > 0u ? mine : 1u; nx = cnt > 0u ? cnt : 1u;
}
__device__ __forceinline__ void xcd_sync(int wv, unsigned* bar, volatile unsigned* st) {
    asm volatile("s_waitcnt vmcnt(0)" ::: "memory");
    __syncthreads();
    if (otid(wv) == 0) {
        const unsigned x = xb_xcc_id();
        __builtin_amdgcn_s_waitcnt(0);
        unsigned nloc = st[0], nx = st[1];
        if (nloc == 0u) { xcd_barrier_complete(bar, x, nloc, nx); st[0] = nloc; st[1] = nx; }
        const unsigned old = xb_add(&bar[XB_XSUB(x)], 1u);
        const unsigned gen = old / nloc;
        if (old + 1u == (gen + 1u) * nloc) {
            __builtin_amdgcn_fence(__ATOMIC_RELEASE, "agent");
            asm volatile("s_waitcnt vmcnt(0)" ::: "memory");
            const unsigned og = xb_add(&bar[XB_TOP], 1u);
            const unsigned tg = og / nx;
            if (og + 1u == (tg + 1u) * nx) xb_add(&bar[XB_TOPGEN], 1u);
            else XB_SPIN(xb_ld(&bar[XB_TOPGEN]) == tg, bar);
            __builtin_amdgcn_fence(__ATOMIC_ACQUIRE, "agent");
            xb_add(&bar[XB_XGEN(x)], 1u);
            asm volatile("s_waitcnt vmcnt(0)" ::: "memory");
        } else {
            XB_SPIN(xb_ld(&bar[XB_XGEN(x)]) == gen, bar);
            __builtin_amdgcn_fence(__ATOMIC_ACQUIRE, "agent");
            asm volatile("s_waitcnt vmcnt(0)" ::: "memory");
        }
    }
    __syncthreads();
}

struct EpiIn { static constexpr int ID = 1; static constexpr bool HAS_MID = false; static constexpr int T1 = -1, T2 = -1;
    static constexpr bool PERM = true, AFTER_DRAIN = false;
    bf16_t* proj; float* dtb; const float* ss;
    __device__ __forceinline__ void operator()(const f32x4 (&acc)[2][2][4][2], const Unit& u, int wr, int wc, int fr, int fq) const {
        const int row0 = u.pm * BM + wr * 64 + fr;
        float rs[2][4];
#pragma unroll
        for (int ai = 0; ai < 2; ++ai)
#pragma unroll
            for (int m = 0; m < 4; ++m) rs[ai][m] = ss[row0 + ai * HALF + m * 16];
#pragma unroll
        for (int ai = 0; ai < 2; ++ai)
#pragma unroll
            for (int m = 0; m < 4; ++m) {
                const int row = row0 + ai * HALF + m * 16;
                const float r = __builtin_amdgcn_rsqf(rs[ai][m] * (1.0f / 1024.0f) + EPSN);
                if (u.pn < 34) {
                    bf16_t* rp = proj + (size_t)row * NPROJ + u.pn * BM + wc * 32 + 8 * fq;
#pragma unroll
                    for (int bj = 0; bj < 2; ++bj) { const f32x4 v0 = acc[ai][bj][m][0] * r, v1 = acc[ai][bj][m][1] * r;
                        u32x4 w; w.x = cvt_pk_bf16(v0[0], v0[1]); w.y = cvt_pk_bf16(v0[2], v0[3]); w.z = cvt_pk_bf16(v1[0], v1[1]); w.w = cvt_pk_bf16(v1[2], v1[3]);
                        *(u32x4*)(rp + bj * HALF) = w; }
                } else if (wc == 0 && fq < 2) {
                    float* dp = dtb + (size_t)row * 16 + 8 * fq;
                    *(f32x4*)dp = acc[ai][0][m][0] * r; *(f32x4*)(dp + 4) = acc[ai][0][m][1] * r;
                }
            }
    }
};
struct EpiMergeF { static constexpr int ID = 2;
    static constexpr bool PERM = true, AFTER_DRAIN = false, HAS_MID = true;
    static constexpr int T1 = 8, T2 = 24;
    const bf16_t* gate; bf16_t* mixb;
    struct Ld2 { u32x4 a[2], b[2]; };
    __device__ __forceinline__ void ld2(Ld2& d, unsigned row, unsigned col0, unsigned offa) const {
        const unsigned go = row * NPROJ + col0 + offa;
#pragma unroll
        for (int bj = 0; bj < 2; ++bj) { d.a[bj] = *(const u32x4*)(gate + go + bj * HALF); d.b[bj] = *(const u32x4*)(gate + go + 1024 + bj * HALF); }
    }
    static __device__ __forceinline__ float ratio(float ga, float gb) { return (1.0f + __builtin_amdgcn_exp2f(gb * -1.44269504f)) * __builtin_amdgcn_rcpf(1.0f + __builtin_amdgcn_exp2f(ga * -1.44269504f)); }
    __device__ __forceinline__ void mid(f32x4 (&acc)[2][2][4][2], const Unit& u, int t, int wr, int wc, int fr, int fq) const {
        const unsigned row0 = u.pm * BM + wr * 64 + fr, col0 = u.pn * BM + wc * 32 + 8 * fq, offa = (t == T1) ? 0u : 1024u;
        Ld2 cur, nxt; ld2(cur, row0, col0, offa);
#pragma unroll
        for (int rr = 0; rr < 8; ++rr) {
            const int ai = rr >> 2, m = rr & 3;
            if (rr < 7) ld2(nxt, row0 + ((rr + 1) >> 2) * HALF + ((rr + 1) & 3) * 16, col0, offa);
            MEMFENCE();
#pragma unroll
            for (int bj = 0; bj < 2; ++bj) { float ga[8], gb[8]; unpack8(cur.a[bj], ga); unpack8(cur.b[bj], gb);
#pragma unroll
                for (int e = 0; e < 4; ++e) { acc[ai][bj][m][0][e] *= ratio(ga[e], gb[e]); acc[ai][bj][m][1][e] *= ratio(ga[4 + e], gb[4 + e]); } }
            MEMFENCE();
            cur = nxt;
        }
    }
    struct Ld1 { u32x4 a[2]; };
    __device__ __forceinline__ void ld1(Ld1& d, unsigned row, unsigned col0) const {
        const unsigned go = row * NPROJ + col0 + 2048u;
#pragma unroll
        for (int bj = 0; bj < 2; ++bj) d.a[bj] = *(const u32x4*)(gate + go + bj * HALF);
    }
    __device__ __forceinline__ void operator()(const f32x4 (&acc)[2][2][4][2], const Unit& u, int wr, int wc, int fr, int fq) const {
        const unsigned row0 = u.pm * BM + wr * 64 + fr, col0 = u.pn * BM + wc * 32 + 8 * fq;
        Ld1 cur, nxt, nx2; ld1(cur, row0, col0); ld1(nxt, row0 + 16, col0);
#pragma unroll
        for (int rr = 0; rr < 8; ++rr) {
            const int ai = rr >> 2, m = rr & 3;
            const unsigned row = row0 + ai * HALF + m * 16, mo = row * DM + col0;
            if (rr < 6) ld1(nx2, row0 + ((rr + 2) >> 2) * HALF + ((rr + 2) & 3) * 16, col0);
            MEMFENCE();
#pragma unroll
            for (int bj = 0; bj < 2; ++bj) { float gw[8]; unpack8(cur.a[bj], gw); const f32x4 v0 = acc[ai][bj][m][0], v1 = acc[ai][bj][m][1];
                u32x4 w; w.x = cvt_pk_bf16(v0[0] * sigmoidf_(gw[0]), v0[1] * sigmoidf_(gw[1])); w.y = cvt_pk_bf16(v0[2] * sigmoidf_(gw[2]), v0[3] * sigmoidf_(gw[3]));
                w.z = cvt_pk_bf16(v1[0] * sigmoidf_(gw[4]), v1[1] * sigmoidf_(gw[5])); w.w = cvt_pk_bf16(v1[2] * sigmoidf_(gw[6]), v1[3] * sigmoidf_(gw[7]));
                *(u32x4*)(mixb + mo + bj * HALF) = w; }
            MEMFENCE();
            cur = nxt; nxt = nx2;
        }
    }
};
struct EpiOut { static constexpr int ID = 4; static constexpr bool HAS_MID = false; static constexpr int T1 = -1, T2 = -1;
    static constexpr bool PERM = true, AFTER_DRAIN = false;
    const float* xa; const float* xb; bf16_t* xres; bf16_t* ub; const float* pg; float* ss; int first;
    struct Ld { f32x4 x[2][2]; };
    __device__ __forceinline__ void ld(Ld& d, const float* xbase, unsigned row, unsigned col0) const {
        const unsigned ro = row * DM + col0;
#pragma unroll
        for (int bj = 0; bj < 2; ++bj) { const unsigned cc = bj * HALF;
            if (first) { d.x[bj][0] = *(const f32x4*)(xbase + ro + cc); d.x[bj][1] = *(const f32x4*)(xbase + ro + cc + 4); }
            else { const u32x4 w = *(const u32x4*)(xres + ro + cc); d.x[bj][0] = (f32x4){bflo(w.x), bfhi(w.x), bflo(w.y), bfhi(w.y)}; d.x[bj][1] = (f32x4){bflo(w.z), bfhi(w.z), bflo(w.w), bfhi(w.w)}; } }
    }
    __device__ __forceinline__ void operator()(const f32x4 (&acc)[2][2][4][2], const Unit& u, int wr, int wc, int fr, int fq) const {
        const int lane = fr + 16 * fq;
        const unsigned row0 = u.pm * BM + wr * 64 + fr, col0 = u.pn * BM + wc * 32 + 8 * fq;
        const bool smp = (u.pm * BM) >= MP;
        const float* xbase = smp ? xb - (size_t)MP * DM : xa;
        f32x4 gv[2][2];
#pragma unroll
        for (int bj = 0; bj < 2; ++bj) { gv[bj][0] = *(const f32x4*)(pg + col0 + bj * HALF); gv[bj][1] = *(const f32x4*)(pg + col0 + bj * HALF + 4); }
        Ld cur, nxt; ld(cur, xbase, row0, col0);
#pragma unroll
        for (int rr = 0; rr < 8; ++rr) {
            const int ai = rr >> 2, m = rr & 3;
            const unsigned row = row0 + ai * HALF + m * 16, ro = row * DM + col0;
            if (rr < 7) ld(nxt, xbase, row0 + ((rr + 1) >> 2) * HALF + ((rr + 1) & 3) * 16, col0);
            MEMFENCE();
            float s = 0.f;
#pragma unroll
            for (int bj = 0; bj < 2; ++bj) {
                const unsigned cc = bj * HALF;
                const f32x4 v0 = cur.x[bj][0] + acc[ai][bj][m][0], v1 = cur.x[bj][1] + acc[ai][bj][m][1];
                u32x4 xw; xw.x = cvt_pk_bf16(v0[0], v0[1]); xw.y = cvt_pk_bf16(v0[2], v0[3]); xw.z = cvt_pk_bf16(v1[0], v1[1]); xw.w = cvt_pk_bf16(v1[2], v1[3]); *(u32x4*)(xres + ro + cc) = xw;
                s += ((v0[0] * v0[0] + v0[1] * v0[1]) + (v0[2] * v0[2] + v0[3] * v0[3])) + ((v1[0] * v1[0] + v1[1] * v1[1]) + (v1[2] * v1[2] + v1[3] * v1[3]));
                const f32x4 q0 = v0 * gv[bj][0], q1 = v1 * gv[bj][1];
                u32x4 w; w.x = cvt_pk_bf16(q0[0], q0[1]); w.y = cvt_pk_bf16(q0[2], q0[3]); w.z = cvt_pk_bf16(q1[0], q1[1]); w.w = cvt_pk_bf16(q1[2], q1[3]); *(u32x4*)(ub + ro + cc) = w;
            }
            s = wsum4(s, lane);
            if (fq == 0) atomicAdd(ss + row, s);
            MEMFENCE();
            cur = nxt;
        }
    }
};
struct EpiPP { static constexpr int ID = 8; static constexpr bool HAS_MID = false; static constexpr int T1 = -1, T2 = -1;
    static constexpr bool PERM = true, AFTER_DRAIN = false;
    bf16_t* pp;
    __device__ __forceinline__ void operator()(const f32x4 (&acc)[2][2][4][2], const Unit& u, int wr, int wc, int fr, int fq) const {
        const int row0 = u.pm * BM + wr * 64 + fr;
#pragma unroll
        for (int ai = 0; ai < 2; ++ai)
#pragma unroll
            for (int m = 0; m < 4; ++m) {
                bf16_t* rp = pp + (size_t)(row0 + ai * HALF + m * 16) * DM + u.pn * BM + wc * 32 + 8 * fq;
#pragma unroll
                for (int bj = 0; bj < 2; ++bj) { const f32x4 v0 = acc[ai][bj][m][0], v1 = acc[ai][bj][m][1];
                    u32x4 w; w.x = cvt_pk_bf16(v0[0], v0[1]); w.y = cvt_pk_bf16(v0[2], v0[3]); w.z = cvt_pk_bf16(v1[0], v1[1]); w.w = cvt_pk_bf16(v1[2], v1[3]);
                    *(u32x4*)(rp + bj * HALF) = w; }
                MEMFENCE();
            }
    }
};
struct EpiGate { static constexpr int ID = 16; static constexpr bool HAS_MID = false; static constexpr int T1 = -1, T2 = -1;
    static constexpr bool PERM = true, AFTER_DRAIN = false;
    float* ya; float* yb; const bf16_t* pp; const float* ssp; bf16_t* hb; const float* ng; float* ssn; bf16_t* xres;
    struct Ld { u32x4 p[2]; u32x4 x[2]; float s; };
    __device__ __forceinline__ void ld(Ld& d, unsigned row, unsigned col0) const {
        const unsigned ro = row * DM + col0; d.s = ssp[row];
#pragma unroll
        for (int bj = 0; bj < 2; ++bj) { d.p[bj] = *(const u32x4*)(pp + ro + bj * HALF); d.x[bj] = *(const u32x4*)(xres + ro + bj * HALF); }
    }
    __device__ __forceinline__ void operator()(const f32x4 (&acc)[2][2][4][2], const Unit& u, int wr, int wc, int fr, int fq) const {
        const int lane = fr + 16 * fq;
        const unsigned row0 = u.pm * BM + wr * 64 + fr, col0 = u.pn * BM + wc * 32 + 8 * fq;
        const bool smp = (u.pm * BM) >= MP;
        float* ybase = smp ? yb - (size_t)MP * DM : ya;
        f32x4 gv[2][2];
#pragma unroll
        for (int bj = 0; bj < 2; ++bj) { gv[bj][0] = hb ? *(const f32x4*)(ng + col0 + bj * HALF) : (f32x4){0.f, 0.f, 0.f, 0.f}; gv[bj][1] = hb ? *(const f32x4*)(ng + col0 + bj * HALF + 4) : (f32x4){0.f, 0.f, 0.f, 0.f}; }
        Ld cur, nxt; ld(cur, row0, col0);
#pragma unroll
        for (int rr = 0; rr < 8; ++rr) {
            const int ai = rr >> 2, m = rr & 3;
            const unsigned row = row0 + ai * HALF + m * 16, ro = row * DM + col0;
            if (rr < 7) ld(nxt, row0 + ((rr + 1) >> 2) * HALF + ((rr + 1) & 3) * 16, col0);
            MEMFENCE();
            const float r = __builtin_amdgcn_rsqf(cur.s * (1.0f / 1024.0f) + EPSN);
            float s = 0.f;
#pragma unroll
            for (int bj = 0; bj < 2; ++bj) {
                const unsigned cc = bj * HALF; float pf8[8], xf8[8]; unpack8(cur.p[bj], pf8); unpack8(cur.x[bj], xf8);
                const f32x4 a0 = acc[ai][bj][m][0] * r, a1 = acc[ai][bj][m][1] * r;
                f32x4 v0, v1;
#pragma unroll
                for (int e = 0; e < 4; ++e) { v0[e] = xf8[e] + sigmoidf_(a0[e]) * pf8[e]; v1[e] = xf8[4 + e] + sigmoidf_(a1[e]) * pf8[4 + e]; }
                if (hb) { s += ((v0[0] * v0[0] + v0[1] * v0[1]) + (v0[2] * v0[2] + v0[3] * v0[3])) + ((v1[0] * v1[0] + v1[1] * v1[1]) + (v1[2] * v1[2] + v1[3] * v1[3]));
                    const f32x4 q0 = v0 * gv[bj][0], q1 = v1 * gv[bj][1];
                    u32x4 w; w.x = cvt_pk_bf16(q0[0], q0[1]); w.y = cvt_pk_bf16(q0[2], q0[3]); w.z = cvt_pk_bf16(q1[0], q1[1]); w.w = cvt_pk_bf16(q1[2], q1[3]); *(u32x4*)(hb + ro + cc) = w;
                    u32x4 xo; xo.x = cvt_pk_bf16(v0[0], v0[1]); xo.y = cvt_pk_bf16(v0[2], v0[3]); xo.z = cvt_pk_bf16(v1[0], v1[1]); xo.w = cvt_pk_bf16(v1[2], v1[3]); *(u32x4*)(xres + ro + cc) = xo; }
                else { *(f32x4*)(ybase + ro + cc) = v0; *(f32x4*)(ybase + ro + cc + 4) = v1; }
            }
            if (hb) { s = wsum4(s, lane); if (fq == 0) atomicAdd(ssn + row, s); }
            MEMFENCE();
            cur = nxt;
        }
    }
};

__device__ __forceinline__ void transpose_job(int wv, const float* src, bf16_t* dst, int K, int Nsrc, int Ndst, bool win_map, float* tile  , int ldd = 0) {
    if (ldd == 0) ldd = K;
    const int tid = otid(wv); const int ntk = K / 64, ntn = Ndst / 64, nt = ntk * ntn;
    for (int t = blockIdx.x; t < nt; t += gridDim.x) {
        const int kt = t % ntk, ntile = t / ntk, k0 = kt * 64, n0 = ntile * 64;
        int srcc = n0, valid = 64;
        if (win_map) { if (n0 < 4608) srcc = n0; else if (n0 < 8704) srcc = n0 + 16; else if (n0 == 8704) { srcc = 4608; valid = 16; } else { srcc = 0; valid = 0; } }
        __syncthreads();
        { const int j = tid & 63, i0 = tid >> 6;
#pragma unroll
          for (int ii = 0; ii < 8; ++ii) { const int i = i0 + 8 * ii; tile[i * 65 + j] = (j < valid) ? src[(size_t)(k0 + i) * Nsrc + srcc + j] : 0.f; } }
        __syncthreads();
        { const int i2 = tid & 31, j0 = tid >> 5;
#pragma unroll
          for (int jj = 0; jj < 4; ++jj) { const int j = j0 + 16 * jj; *(unsigned*)(dst + (size_t)(n0 + j) * ldd + k0 + 2 * i2) = cvt_pk_bf16(tile[(2 * i2) * 65 + j], tile[(2 * i2 + 1) * 65 + j]); } }
    }
}
__device__ __forceinline__ void phase_weights(int wv, const Params& P, unsigned char* lds) {
    float* tile = (float*)lds;
    for (int l = 0; l < 2; ++l) {
        transpose_job(wv, P.in[I_WIN] + (size_t)l * 1024 * 8720, (bf16_t*)(P.ws + WS_WIN) + (size_t)l * NWIN * 1024, 1024, 8720, NWIN, true, tile);
        transpose_job(wv, P.in[I_WOA] + (size_t)l * 512 * 1024, (bf16_t*)(P.ws + WS_WCAT) + (size_t)l * 1024 * 2048 + OC_A, 512, 1024, 1024, false, tile, 2048);
        transpose_job(wv, P.in[I_WOB] + (size_t)l * 1024 * 1024, (bf16_t*)(P.ws + WS_WCAT) + (size_t)l * 1024 * 2048 + OC_B, 1024, 1024, 1024, false, tile, 2048);
        transpose_job(wv, P.in[I_WOC] + (size_t)l * 512 * 1024, (bf16_t*)(P.ws + WS_WCAT) + (size_t)l * 1024 * 2048 + OC_C, 512, 1024, 1024, false, tile, 2048);
        transpose_job(wv, P.in[I_WOUT] + (size_t)l * 1024 * 1024, (bf16_t*)(P.ws + WS_WOUT) + (size_t)l * 1024 * 1024, 1024, 1024, 1024, false, tile);
        transpose_job(wv, P.in[I_WPG] + (size_t)l * 1024 * 1024, (bf16_t*)(P.ws + WS_WPG) + (size_t)l * 1024 * 1024, 1024, 1024, 1024, false, tile);
        transpose_job(wv, P.in[I_WPP] + (size_t)l * 256 * 1024, (bf16_t*)(P.ws + WS_WPP) + (size_t)l * 1024 * 256, 256, 1024, 1024, false, tile);
    }
    const size_t gt = (size_t)blockIdx.x * 512 + otid(wv), gs = (size_t)gridDim.x * 512;
    { const size_t n4 = (size_t)2 * 8 * 512 * 512 / 4; const f32x4* ck = (const f32x4*)P.in[I_CK]; const f32x4* cv = (const f32x4*)P.in[I_CV]; u32x2* dk = (u32x2*)(P.ws + WS_KC); u32x2* dv = (u32x2*)(P.ws + WS_VC);
      for (size_t i = gt; i < n4; i += gs) { const f32x4 a = ck[i], b = cv[i]; u32x2 w; w.x = cvt_pk_bf16(a[0], a[1]); w.y = cvt_pk_bf16(a[2], a[3]); dk[i] = w; w.x = cvt_pk_bf16(b[0], b[1]); w.y = cvt_pk_bf16(b[2], b[3]); dv[i] = w; } }
    if (gt < 16384) { const int e = (int)gt, ln = e & 63, gate = (e >> 6) & 1, ks = (e >> 7) & 1, ct = (e >> 8) & 3, kb = (e >> 10) & 7, ll = e >> 13, fr_ = ln & 15, fq_ = ln >> 4;
        const float* wsrc = (gate ? P.in[I_WIG] : P.in[I_WRG]) + ((size_t)(ll * 8 + kb) * 64 + 32 * ks + 8 * fq_) * 64 + 16 * ct + fr_;
        float a[8];
#pragma unroll
        for (int q = 0; q < 8; ++q) a[q] = wsrc[q * 64];
        ((u32x4*)(P.ws + WS_LWF))[e] = pack8(a); }
    { float* ss = (float*)(P.ws + WS_SS); const size_t n = (size_t)NG * 4 * MLOC; for (size_t i = gt; i < n; i += gs) if ((((unsigned)i / (unsigned)MLOC) & 3u) != 0u) ss[i] = 0.f;
      if (gt < 256) ((unsigned*)(P.ws + WS_CTR))[gt] = 0u;
      if (gt < XCD_BAR_WORDS) ((unsigned*)(P.ws + WS_BAR))[gt] = 0u; }
}

__device__ __forceinline__ void phase_prep(int wv, const Params& P, int g) {
    const int M = (g == 0) ? MLOC : MP; const int tid = otid(wv); const int w = tid >> 6, lane = tid & 63;
    bf16_t* hb = (bf16_t*)(P.ws + WS_HBUF); float* ss = (float*)(P.ws + WS_SS) + (size_t)(g * 4 + 0) * MLOC; bf16_t* pb = (bf16_t*)(P.ws + WS_PBUF);
    const float* ng = P.in[I_NG];
    f32x4 gv[4];
#pragma unroll
    for (int k = 0; k < 4; ++k) gv[k] = *(const f32x4*)(ng + k * 256 + lane * 4);
    for (int row = blockIdx.x * 8 + w; row < M; row += gridDim.x * 8) {
        const float* xr = x_row(P, g, row); float s = 0.f;
#pragma unroll
        for (int k = 0; k < 4; ++k) { const f32x4 v = *(const f32x4*)(xr + k * 256 + lane * 4); s += (v[0] * v[0] + v[1] * v[1]) + (v[2] * v[2] + v[3] * v[3]);
            const f32x4 q = v * gv[k]; u32x2 o; o.x = cvt_pk_bf16(q[0], q[1]); o.y = cvt_pk_bf16(q[2], q[3]); *(u32x2*)(hb + (size_t)row * DM + k * 256 + lane * 4) = o; }
#pragma unroll
        for (int o = 32; o >= 1; o >>= 1) s += bperm(s, lane ^ o);
        if (lane == 0) ss[row] = s;
#pragma unroll
        for (int l = 0; l < 2; ++l) {
            const float* pr = row < MP ? P.in[I_PP] + (((size_t)l * NB * SEQ) + (size_t)g * MP + row) * 256 : P.in[I_PS] + (((size_t)l * MSMP) + (row - MP)) * 256;
            const f32x4 v = *(const f32x4*)(pr + lane * 4); u32x2 o; o.x = cvt_pk_bf16(v[0], v[1]); o.y = cvt_pk_bf16(v[2], v[3]);
            *(u32x2*)(pb + ((size_t)l * MLOC + row) * 256 + lane * 4) = o;
        }
    }
}

__device__ __forceinline__ void attn_item(int wv, const Params& P, int g, int l, int item, bool sample, unsigned char* lds) {
    const int tid = otid(wv), w = tid >> 6, lane = tid & 63, fr = lane & 15, fq = lane >> 4, h = w;
    bf16_t* vt = (bf16_t*)(lds + w * 19712);
    bf16_t* qs = (bf16_t*)(lds + w * 19712 + 9216);
    float* btab = (float*)(lds + w * 19712 + 18432);
    const float* rb = P.in[I_RB] + (size_t)(l * 8 + h) * 257;
    for (int i = lane; i < 257; i += 64) btab[i] = rb[i] * 1.44269504f;
    const float bconst = rb[256] * 1.44269504f;
    const bf16_t* proj = (const bf16_t*)(P.ws + WS_PROJ);
    int qrow0, nq, ntile, bl = 0, c = 0, sb = 0;
    if (!sample) { bl = item >> 6; c = item & 63; qrow0 = bl * SEQ + c * 64; nq = 64; ntile = (c < 8 ? c : 8) + 1; }
    else { sb = item; qrow0 = MP + sb * SL; nq = SL; ntile = 9; }
    float gq[2][8];
#pragma unroll
    for (int ks = 0; ks < 2; ++ks)
#pragma unroll
        for (int e = 0; e < 8; ++e) gq[ks][e] = P.in[I_QN][l * 64 + 32 * ks + 8 * fq + e] * (0.125f * 1.44269504f);
    const float* gkp = P.in[I_KN] + l * 64 + 8 * fq;
#pragma unroll
    for (int qt = 0; qt < 4; ++qt) {
        int qi = 16 * qt + fr; if (qi > nq - 1) qi = nq - 1;
        const bf16_t* qp = proj + (size_t)(qrow0 + qi) * NPROJ + C_Q + h * 64 + 8 * fq;
        float f0[8], f1[8]; unpack8(*(const u32x4*)qp, f0); unpack8(*(const u32x4*)(qp + 32), f1);
        float s = 0.f;
#pragma unroll
        for (int e = 0; e < 8; ++e) s += f0[e] * f0[e] + f1[e] * f1[e];
        s = wsum4(s, lane); const float r = __builtin_amdgcn_rsqf(s * (1.0f / 64.0f) + EPSN);
#pragma unroll
        for (int e = 0; e < 8; ++e) { f0[e] *= r * gq[0][e]; f1[e] *= r * gq[1][e]; }
        *(u32x4*)(qs + (16 * qt + fr) * 72 + 8 * fq) = pack8(f0); *(u32x4*)(qs + (16 * qt + fr) * 72 + 32 + 8 * fq) = pack8(f1);
    }
    float mrun[4], lrun[4]; f32x4 o[4][4];
#pragma unroll
    for (int qt = 0; qt < 4; ++qt) { mrun[qt] = -1e30f; lrun[qt] = 0.f;
#pragma unroll
        for (int dt = 0; dt < 4; ++dt) o[dt][qt] = (f32x4){0.f, 0.f, 0.f, 0.f}; }
    LDSWAIT();
    auto desc = [&](int ti, const bf16_t*& kp, const bf16_t*& vp, int& stride, int& donorm, int& relbase, int& nvalid, float*& ko, float*& vo) {
        ko = nullptr; vo = nullptr;
        if (!sample) { const int j = ntile - 1 - ti, kc = c - j; const size_t r0 = (size_t)(bl * SEQ + kc * 64);
            kp = proj + r0 * NPROJ + C_K + h * 64; vp = proj + r0 * NPROJ + C_V + h * 64; stride = NPROJ; donorm = 1; relbase = 64 * j; nvalid = 64;
            if (j == 0 && c >= 56) { const size_t orow = ((size_t)(l * NB + g * GB + bl) * 512 + (c - 56) * 64) * 512 + h * 64; ko = P.out + O_PK + orow; vo = P.out + O_PV + orow; } }
        else if (ti < 8) { const size_t r0 = ((size_t)(l * NSB + sb) * 512 + ti * 64) * 512 + h * 64;
            kp = (const bf16_t*)(P.ws + WS_KC) + r0; vp = (const bf16_t*)(P.ws + WS_VC) + r0; stride = 512; donorm = 0; relbase = 512 - 64 * ti; nvalid = 64; }
        else { const size_t r0 = (size_t)(MP + sb * SL);
            kp = proj + r0 * NPROJ + C_K + h * 64; vp = proj + r0 * NPROJ + C_V + h * 64; stride = NPROJ; donorm = 1; relbase = 0; nvalid = SL;
            const size_t orow = ((size_t)(l * NSB + sb) * SL) * 512 + h * 64; ko = P.out + O_SK + orow; vo = P.out + O_SV + orow; }
    };
    u32x4 kraw[4][2];
    auto loadk = [&](int ti) {
        const bf16_t* kp; const bf16_t* vp; int stride, donorm, relbase, nvalid; float* ko; float* vo; desc(ti, kp, vp, stride, donorm, relbase, nvalid, ko, vo);
        asm volatile("" : "+s"(stride));
#pragma unroll
        for (int kt = 0; kt < 4; ++kt) { const int kk = 32 * (kt >> 1) + 8 * (fr >> 2) + 4 * (kt & 1) + (fr & 3); const int kl = kk < nvalid ? kk : nvalid - 1;
            const unsigned ko32 = ((unsigned)kl * (unsigned)stride + 8u * fq) * 2u; kraw[kt][0] = *(const u32x4*)((const char*)kp + ko32); kraw[kt][1] = *(const u32x4*)((const char*)kp + ko32 + 64u); }
    };
    for (int ti = 0; ti < ntile; ++ti) {
        const bf16_t* kp; const bf16_t* vp; int stride, donorm, relbase, nvalid; float* ko; float* vo; desc(ti, kp, vp, stride, donorm, relbase, nvalid, ko, vo);
        MEMFENCE();
        u32x4 va[4], vb[4];
        { int st_ = stride; asm volatile("" : "+s"(st_)); stride = st_; }
        { const int i = lane & 31;
#pragma unroll
          for (int pp = 0; pp < 4; ++pp) { const int dg = (lane >> 5) + 2 * pp; int k0 = 2 * i, k1 = 2 * i + 1; if (k0 >= nvalid) k0 = nvalid - 1; if (k1 >= nvalid) k1 = nvalid - 1;
              va[pp] = *(const u32x4*)((const char*)vp + ((unsigned)k0 * (unsigned)stride + 8u * dg) * 2u); vb[pp] = *(const u32x4*)((const char*)vp + ((unsigned)k1 * (unsigned)stride + 8u * dg) * 2u); } }
        loadk(ti);
        bf16x8 kf[4][2];
        float gk[2][8];
        if (donorm) {
#pragma unroll
            for (int ks = 0; ks < 2; ++ks) { const f32x4 a = *(const f32x4*)(gkp + 32 * ks), b = *(const f32x4*)(gkp + 32 * ks + 4);
#pragma unroll
                for (int e = 0; e < 4; ++e) { gk[ks][e] = a[e]; gk[ks][4 + e] = b[e]; } }
        } else {
#pragma unroll
            for (int ks = 0; ks < 2; ++ks)
#pragma unroll
                for (int e = 0; e < 8; ++e) gk[ks][e] = 1.f;
        }
#pragma unroll
        for (int kt = 0; kt < 4; ++kt) {
            const int kk = 32 * (kt >> 1) + 8 * (fr >> 2) + 4 * (kt & 1) + (fr & 3); const bool okk = kk < nvalid;
            const u32x4 r0 = kraw[kt][0], r1 = kraw[kt][1];
            if (donorm) {
                float f0[8], f1[8]; unpack8(r0, f0); unpack8(r1, f1);
                float s = 0.f;
#pragma unroll
                for (int e = 0; e < 8; ++e) s += f0[e] * f0[e] + f1[e] * f1[e];
                s = wsum4(s, lane); const float r = __builtin_amdgcn_rsqf(s * (1.0f / 64.0f) + EPSN);
#pragma unroll
                for (int e = 0; e < 8; ++e) { f0[e] *= r * gk[0][e]; f1[e] *= r * gk[1][e]; }
                if (ko && okk) { float* d = ko + (size_t)kk * 512 + 8 * fq; *(f32x4*)d = (f32x4){f0[0], f0[1], f0[2], f0[3]}; *(f32x4*)(d + 4) = (f32x4){f0[4], f0[5], f0[6], f0[7]};
                    *(f32x4*)(d + 32) = (f32x4){f1[0], f1[1], f1[2], f1[3]}; *(f32x4*)(d + 36) = (f32x4){f1[4], f1[5], f1[6], f1[7]}; }
                kf[kt][0] = as_bf8(pack8(f0)); kf[kt][1] = as_bf8(pack8(f1));
            } else { kf[kt][0] = as_bf8(r0); kf[kt][1] = as_bf8(r1); }
        }
        { const int i = lane & 31;
#pragma unroll
          for (int pp = 0; pp < 4; ++pp) {
              const int dg = (lane >> 5) + 2 * pp; const int k0 = 2 * i, k1 = 2 * i + 1; const bool ok0 = k0 < nvalid, ok1 = k1 < nvalid;
              const u32x4 a = va[pp], b = vb[pp];
              unsigned* dst = (unsigned*)(vt + (8 * dg) * 72 + 2 * i);
              dst[0 * 36] = (a.x & 0xffffu) | (b.x << 16); dst[1 * 36] = (a.x >> 16) | (b.x & 0xffff0000u);
              dst[2 * 36] = (a.y & 0xffffu) | (b.y << 16); dst[3 * 36] = (a.y >> 16) | (b.y & 0xffff0000u);
              dst[4 * 36] = (a.z & 0xffffu) | (b.z << 16); dst[5 * 36] = (a.z >> 16) | (b.z & 0xffff0000u);
              dst[6 * 36] = (a.w & 0xffffu) | (b.w << 16); dst[7 * 36] = (a.w >> 16) | (b.w & 0xffff0000u);
              if (vo) { float f[8];
                  if (ok0) { unpack8(a, f); float* d = vo + (size_t)k0 * 512 + 8 * dg; *(f32x4*)d = (f32x4){f[0], f[1], f[2], f[3]}; *(f32x4*)(d + 4) = (f32x4){f[4], f[5], f[6], f[7]}; }
                  if (ok1) { unpack8(b, f); float* d = vo + (size_t)k1 * 512 + 8 * dg; *(f32x4*)d = (f32x4){f[0], f[1], f[2], f[3]}; *(f32x4*)(d + 4) = (f32x4){f[4], f[5], f[6], f[7]}; } }
          } }
        const bool cbias = relbase >= 191;
        LDSWAIT();
#pragma unroll
        for (int qt = 0; qt < 4; ++qt) {
            f32x4 s[4];
            { const bf16x8 q0 = *(const bf16x8*)(qs + (16 * qt + fr) * 72 + 8 * fq), q1 = *(const bf16x8*)(qs + (16 * qt + fr) * 72 + 32 + 8 * fq);
#pragma unroll
              for (int kt = 0; kt < 4; ++kt) { s[kt] = MFMA16(kf[kt][0], q0, ((f32x4){0.f, 0.f, 0.f, 0.f})); s[kt] = MFMA16(kf[kt][1], q1, s[kt]); } }
            const int qi = 16 * qt + fr; float mx = -1e30f;
#pragma unroll
            for (int kt = 0; kt < 4; ++kt)
#pragma unroll
                for (int jj = 0; jj < 4; ++jj) {
                    const int kk = 32 * (kt >> 1) + 8 * fq + 4 * (kt & 1) + jj;
                    float bias;
                    if (cbias) bias = bconst; else { int rel = relbase + qi - kk; rel = rel < -128 ? -128 : (rel > 128 ? 128 : rel); bias = btab[rel + 128]; }
                    float v = s[kt][jj] + bias; if (kk >= nvalid) v = -1e30f;
                    s[kt][jj] = v; mx = fmaxf(mx, v);
                }
            mx = wmax4(mx, lane);
            const float mnew = fmaxf(mrun[qt], mx); const float alpha = __builtin_amdgcn_exp2f(mrun[qt] - mnew); mrun[qt] = mnew;
            float ps = 0.f;
#pragma unroll
            for (int kt = 0; kt < 4; ++kt)
#pragma unroll
                for (int jj = 0; jj < 4; ++jj) { const float p = __builtin_amdgcn_exp2f(s[kt][jj] - mnew); s[kt][jj] = p; ps += p; }
            lrun[qt] = lrun[qt] * alpha + ps;
            bf16x8 pf[2];
#pragma unroll
            for (int sl = 0; sl < 2; ++sl) { u32x4 pw; pw.x = cvt_pk_bf16(s[2 * sl][0], s[2 * sl][1]); pw.y = cvt_pk_bf16(s[2 * sl][2], s[2 * sl][3]);
                pw.z = cvt_pk_bf16(s[2 * sl + 1][0], s[2 * sl + 1][1]); pw.w = cvt_pk_bf16(s[2 * sl + 1][2], s[2 * sl + 1][3]); pf[sl] = as_bf8(pw); }
#pragma unroll
            for (int dt = 0; dt < 4; ++dt) {
                const bf16x8 v0 = *(const bf16x8*)(vt + (16 * dt + fr) * 72 + 8 * fq), v1 = *(const bf16x8*)(vt + (16 * dt + fr) * 72 + 32 + 8 * fq);
                o[dt][qt] *= alpha; o[dt][qt] = MFMA16(v0, pf[0], o[dt][qt]); o[dt][qt] = MFMA16(v1, pf[1], o[dt][qt]);
            }
        }
        LDSWAIT();
    }
    bf16_t* oa = (bf16_t*)(P.ws + WS_OCAT) + OC_A;
#pragma unroll
    for (int qt = 0; qt < 4; ++qt) {
        const int qi = 16 * qt + fr; const float inv = __builtin_amdgcn_rcpf(wsum4(lrun[qt], lane));
        if (qi < nq) {
            const size_t row = (size_t)(qrow0 + qi);
#pragma unroll
            for (int dt = 0; dt < 4; ++dt) {
                const int d = h * 64 + 16 * dt + 4 * fq;
                const u32x2 gw = *(const u32x2*)(proj + row * NPROJ + C_GA + d);
                const f32x4 v = o[dt][qt] * inv;
                u32x2 ow; ow.x = cvt_pk_bf16(v[0] * siluf_(bflo(gw.x)), v[1] * siluf_(bfhi(gw.x))); ow.y = cvt_pk_bf16(v[2] * siluf_(bflo(gw.y)), v[3] * siluf_(bfhi(gw.y)));
                *(u32x2*)(oa + row * OCW + d) = ow;
            }
        }
    }
}

constexpr int SX_ROW = 0, SX_T = 33792, SB_ROW = 70656, SB_T = 79872, SC_ROW = 89088, S_DT = 98304, S_CUM = 100352, S_SSP = 102400;
__device__ __forceinline__ void ssd_item(int wv, const Params& P, int g, int l, int item, int mode, unsigned char* lds) {
    const bool sample = (mode == 0);
    const int tid = otid(wv), w = tid >> 6, lane = tid & 63, fr = lane & 15, fq = lane >> 4, hh = w >> 1, ph = w & 1;
    const int gi = item & 3, bi = sample ? item >> 2 : item >> 8, c0 = sample ? 0 : (item >> 2) & 63;
    const int row0 = sample ? MP + bi * SL : bi * SEQ, L = sample ? SL : SEQ;
    const int head = 4 * gi + hh;
    const bf16_t* sbuf = (const bf16_t*)(P.ws + WS_SSDS) + ((size_t)(bi * 64 + c0) * 16 + head) * 4096;
    const float a_h = -__expf(P.in[I_ALOG][l * 16 + head]), dtbias = P.in[I_DTB][l * 16 + head], dsk = P.in[I_DSK][l * 16 + head];
    const bf16_t* proj = (const bf16_t*)(P.ws + WS_PROJ); const float* dtbuf = (const float*)(P.ws + WS_DT); bf16_t* ob = (bf16_t*)(P.ws + WS_OCAT) + OC_B;
    bf16_t* Xrow = (bf16_t*)(lds + SX_ROW); bf16_t* Xt = (bf16_t*)(lds + SX_T); bf16_t* Brow = (bf16_t*)(lds + SB_ROW); bf16_t* Bt = (bf16_t*)(lds + SB_T); bf16_t* Crow = (bf16_t*)(lds + SC_ROW);
    float* dtl = (float*)(lds + S_DT) + w * 64; float* cuml = (float*)(lds + S_CUM) + w * 64; float* ssp = (float*)(lds + S_SSP);
    f32x4 hacc[4][2];
#pragma unroll
    for (int nt = 0; nt < 4; ++nt)
#pragma unroll
        for (int pl = 0; pl < 2; ++pl) {
            if (sample) hacc[nt][pl] = *(const f32x4*)(P.in[I_SSM] + (((size_t)(l * NSB + bi) * 16 + head) * 64 + 16 * (2 * ph + pl) + fr) * 64 + 16 * nt + 4 * fq);
            else if (mode == 2) { const u32x2 hw = *(const u32x2*)(sbuf + (16 * (2 * ph + pl) + fr) * 64 + 16 * nt + 4 * fq); hacc[nt][pl] = (f32x4){bflo(hw.x), bfhi(hw.x), bflo(hw.y), bfhi(hw.y)}; }
            else hacc[nt][pl] = (f32x4){0.f, 0.f, 0.f, 0.f};
        }
    const float* gnp = P.in[I_SNG] + l * 1024 + 256 * gi + 64 * hh + 32 * ph + 4 * fq;
    const int cg8 = tid % 48, seg = tid / 48;
    int xch; if (cg8 < 32) xch = 256 * gi + 8 * cg8; else if (cg8 < 40) xch = 1024 + 64 * gi + 8 * (cg8 - 32); else xch = 1280 + 64 * gi + 8 * (cg8 - 40);
    {
        const int t0 = c0 * 64;
        __syncthreads();
        const float dtraw = dtbuf[(size_t)(row0 + ((t0 + lane) < L ? (t0 + lane) : L - 1)) * 16 + head];
        MEMFENCE();
        if (tid < 384) {
            u32x4 rowp[8];
            bf16_t* xact = (bf16_t*)(P.ws + WS_XACT) + (size_t)item * (64 * 384) + (size_t)(8 * seg) * 384 + 8 * cg8;
            if (mode == 2) {
#pragma unroll
                for (int tk = 0; tk < 8; ++tk) rowp[tk] = *(const u32x4*)(xact + tk * 384);
            } else {
            float cw[4][8], acc[8][8];
            { const float* cwp = P.in[I_CWB] + (size_t)l * 4 * 1536 + xch; const float* cbp = P.in[I_CBB] + l * 1536 + xch;
#pragma unroll
              for (int k = 0; k < 4; ++k) { const f32x4 a = *(const f32x4*)(cwp + k * 1536), b = *(const f32x4*)(cwp + k * 1536 + 4); cw[k][0] = a[0]; cw[k][1] = a[1]; cw[k][2] = a[2]; cw[k][3] = a[3]; cw[k][4] = b[0]; cw[k][5] = b[1]; cw[k][6] = b[2]; cw[k][7] = b[3]; }
              const f32x4 a = *(const f32x4*)cbp, b = *(const f32x4*)(cbp + 4);
#pragma unroll
              for (int tk = 0; tk < 8; ++tk) { acc[tk][0] = a[0]; acc[tk][1] = a[1]; acc[tk][2] = a[2]; acc[tk][3] = a[3]; acc[tk][4] = b[0]; acc[tk][5] = b[1]; acc[tk][6] = b[2]; acc[tk][7] = b[3]; } }
#pragma unroll
            for (int r = 0; r < 11; ++r) {
                const int t = t0 + 8 * seg - 3 + r; float xv[8];
                if (t < 0) {
                    if (sample) { const float* sp = P.in[I_SCB] + ((size_t)(l * NSB + bi) * 3 + (3 + t)) * 1536 + xch; const f32x4 a = *(const f32x4*)sp, b = *(const f32x4*)(sp + 4);
                        xv[0] = a[0]; xv[1] = a[1]; xv[2] = a[2]; xv[3] = a[3]; xv[4] = b[0]; xv[5] = b[1]; xv[6] = b[2]; xv[7] = b[3]; }
                    else {
#pragma unroll
                        for (int e = 0; e < 8; ++e) xv[e] = 0.f; }
                } else { const int tl = t < L ? t : L - 1; unpack8(*(const u32x4*)(proj + (size_t)(row0 + tl) * NPROJ + C_XBC + xch), xv); }
#pragma unroll
                for (int k = 0; k < 4; ++k) { const int tk = r - k; if (tk >= 0 && tk < 8) {
#pragma unroll
                    for (int e = 0; e < 8; ++e) acc[tk][e] += cw[k][e] * xv[e]; } }
            }
#pragma unroll
            for (int tk = 0; tk < 8; ++tk)
#pragma unroll
                for (int e = 0; e < 8; ++e) acc[tk][e] = siluf_(acc[tk][e]);
#pragma unroll
                for (int tk = 0; tk < 8; ++tk) rowp[tk] = pack8(acc[tk]);
                if (mode == 1) {
#pragma unroll
                    for (int tk = 0; tk < 8; ++tk) *(u32x4*)(xact + tk * 384) = rowp[tk];
                }
            }
            bf16_t* rdst; int rstride; bf16_t* tdst = nullptr;
            if (cg8 < 32) { rdst = Xrow + 8 * cg8; rstride = 264; tdst = Xt + (8 * cg8) * 72; }
            else if (cg8 < 40) { rdst = Brow + 8 * (cg8 - 32); rstride = 72; tdst = Bt + (8 * (cg8 - 32)) * 72; }
            else { rdst = Crow + 8 * (cg8 - 40); rstride = 72; }
#pragma unroll
            for (int tk = 0; tk < 8; ++tk) *(u32x4*)(rdst + (8 * seg + tk) * rstride) = rowp[tk];
            if (tdst) {
#pragma unroll
                for (int e = 0; e < 8; ++e) { const unsigned sel = (e & 1) ? 0x07060302u : 0x05040100u; u32x4 tw;
                    tw.x = __builtin_amdgcn_perm(rowp[1][e >> 1], rowp[0][e >> 1], sel); tw.y = __builtin_amdgcn_perm(rowp[3][e >> 1], rowp[2][e >> 1], sel);
                    tw.z = __builtin_amdgcn_perm(rowp[5][e >> 1], rowp[4][e >> 1], sel); tw.w = __builtin_amdgcn_perm(rowp[7][e >> 1], rowp[6][e >> 1], sel);
                    *(u32x4*)(tdst + e * 72 + 8 * seg) = tw; }
            }
        }
        { const int t = t0 + lane;
          float dtv = softplusf_(dtraw + dtbias); if (t >= L) dtv = 0.f;
          float cum = dtv * (a_h * 1.44269504f);
#pragma unroll
          for (int off = 1; off < 64; off <<= 1) { const float v = bperm(cum, (lane - off) & 63); if (lane >= off) cum += v; }
          dtl[lane] = dtv; cuml[lane] = cum; }
        __syncthreads();
        const float clast = cuml[63];
        bf16x8 xtf[2][2];
#pragma unroll
        for (int pl = 0; pl < 2; ++pl)
#pragma unroll
            for (int s = 0; s < 2; ++s) xtf[pl][s] = *(const bf16x8*)(Xt + (64 * hh + 16 * (2 * ph + pl) + fr) * 72 + 32 * s + 8 * fq);
        bf16x8 hf[2][2];
#pragma unroll
        for (int s2 = 0; s2 < 2; ++s2)
#pragma unroll
            for (int pl = 0; pl < 2; ++pl) { u32x4 hw; hw.x = cvt_pk_bf16(hacc[2 * s2][pl][0], hacc[2 * s2][pl][1]); hw.y = cvt_pk_bf16(hacc[2 * s2][pl][2], hacc[2 * s2][pl][3]);
                hw.z = cvt_pk_bf16(hacc[2 * s2 + 1][pl][0], hacc[2 * s2 + 1][pl][1]); hw.w = cvt_pk_bf16(hacc[2 * s2 + 1][pl][2], hacc[2 * s2 + 1][pl][3]); hf[s2][pl] = as_bf8(hw); }
        f32x4 vv[2][4];
        if (mode != 1) {
#pragma unroll
        for (int it = 0; it < 4; ++it) {
            const int i = 16 * it + fr; const float ci = cuml[i];
            u32x2 zr[2];
            { const int t = t0 + i; const int tl = t < L ? t : L - 1;
#pragma unroll
              for (int pl = 0; pl < 2; ++pl) zr[pl] = *(const u32x2*)(proj + (size_t)(row0 + tl) * NPROJ + C_Z + 256 * gi + 64 * hh + 16 * (2 * ph + pl) + 4 * fq); }
            const bf16x8 cf0 = *(const bf16x8*)(Crow + i * 72 + 8 * fq), cf1 = *(const bf16x8*)(Crow + i * 72 + 32 + 8 * fq);
            f32x4 ain[2] = {(f32x4){0.f, 0.f, 0.f, 0.f}, (f32x4){0.f, 0.f, 0.f, 0.f}};
#pragma unroll
            for (int s = 0; s < 2; ++s) {
                if (s == 1 && it < 2) continue;
                f32x4 cb[2];
#pragma unroll
                for (int t = 0; t < 2; ++t) { const int jrow = 32 * s + 8 * (fr >> 2) + 4 * t + (fr & 3);
                    const bf16x8 a0 = *(const bf16x8*)(Brow + jrow * 72 + 8 * fq), a1 = *(const bf16x8*)(Brow + jrow * 72 + 32 + 8 * fq);
                    cb[t] = MFMA16(a0, cf0, ((f32x4){0.f, 0.f, 0.f, 0.f})); cb[t] = MFMA16(a1, cf1, cb[t]); }
                float wv[8];
                { const f32x4 ca = *(const f32x4*)(cuml + 32 * s + 8 * fq), cb2 = *(const f32x4*)(cuml + 32 * s + 8 * fq + 4), da = *(const f32x4*)(dtl + 32 * s + 8 * fq), db = *(const f32x4*)(dtl + 32 * s + 8 * fq + 4);
#pragma unroll
                  for (int ii = 0; ii < 8; ++ii) { const int j = 32 * s + 8 * fq + ii; const float cbv = cb[ii >> 2][ii & 3]; const float cjv = ii < 4 ? ca[ii & 3] : cb2[ii & 3], djv = ii < 4 ? da[ii & 3] : db[ii & 3];
                      wv[ii] = (j <= i) ? cbv * __builtin_amdgcn_exp2f(ci - cjv) * djv : 0.f; } }
                const bf16x8 wf = as_bf8(pack8(wv));
#pragma unroll
                for (int pl = 0; pl < 2; ++pl) ain[pl] = MFMA16(xtf[pl][s], wf, ain[pl]);
            }
            f32x4 ast[2] = {(f32x4){0.f, 0.f, 0.f, 0.f}, (f32x4){0.f, 0.f, 0.f, 0.f}};
#pragma unroll
            for (int s2 = 0; s2 < 2; ++s2) { const u32x2 c0 = *(const u32x2*)(Crow + i * 72 + 32 * s2 + 4 * fq), c1 = *(const u32x2*)(Crow + i * 72 + 32 * s2 + 16 + 4 * fq);
                u32x4 cw4; cw4.x = c0.x; cw4.y = c0.y; cw4.z = c1.x; cw4.w = c1.y; const bf16x8 cf2 = as_bf8(cw4);
#pragma unroll
                for (int pl = 0; pl < 2; ++pl) ast[pl] = MFMA16(hf[s2][pl], cf2, ast[pl]); }
            const float ei = __builtin_amdgcn_exp2f(ci); float sq = 0.f;
#pragma unroll
            for (int pl = 0; pl < 2; ++pl) { const u32x2 xw = *(const u32x2*)(Xrow + i * 264 + 64 * hh + 16 * (2 * ph + pl) + 4 * fq);
                const float x0 = bflo(xw.x), x1 = bfhi(xw.x), x2 = bflo(xw.y), x3 = bfhi(xw.y); const u32x2 zw = zr[pl];
                f32x4 y; y[0] = (ain[pl][0] + ei * ast[pl][0] + dsk * x0) * siluf_(bflo(zw.x)); y[1] = (ain[pl][1] + ei * ast[pl][1] + dsk * x1) * siluf_(bfhi(zw.x));
                y[2] = (ain[pl][2] + ei * ast[pl][2] + dsk * x2) * siluf_(bflo(zw.y)); y[3] = (ain[pl][3] + ei * ast[pl][3] + dsk * x3) * siluf_(bfhi(zw.y));
                vv[pl][it] = y; sq += (y[0] * y[0] + y[1] * y[1]) + (y[2] * y[2] + y[3] * y[3]); }
            sq = wsum4(sq, lane); if (fq == 0) ssp[w * 64 + i] = sq;
        }
        }
        if (mode != 2) { const float el = __builtin_amdgcn_exp2f(clast);
          if (mode == 1 && ph == 0 && lane == 0) ((float*)(P.ws + WS_ACB))[(size_t)(bi * 64 + c0) * 16 + head] = el;
#pragma unroll
          for (int nt = 0; nt < 4; ++nt)
#pragma unroll
              for (int pl = 0; pl < 2; ++pl) hacc[nt][pl] *= el;
#pragma unroll
          for (int s = 0; s < 2; ++s) {
              float dl[8];
              { const f32x4 ca = *(const f32x4*)(cuml + 32 * s + 8 * fq), cb2 = *(const f32x4*)(cuml + 32 * s + 8 * fq + 4), da = *(const f32x4*)(dtl + 32 * s + 8 * fq), db = *(const f32x4*)(dtl + 32 * s + 8 * fq + 4);
#pragma unroll
                for (int ii = 0; ii < 4; ++ii) { dl[ii] = __builtin_amdgcn_exp2f(clast - ca[ii]) * da[ii]; dl[4 + ii] = __builtin_amdgcn_exp2f(clast - cb2[ii]) * db[ii]; } }
#pragma unroll
              for (int pl = 0; pl < 2; ++pl) { float xf[8]; union { bf16x8 b; u32x4 u; } cv; cv.b = xtf[pl][s]; unpack8(cv.u, xf);
#pragma unroll
                  for (int ii = 0; ii < 8; ++ii) xf[ii] *= dl[ii];
                  const bf16x8 xdf = as_bf8(pack8(xf));
#pragma unroll
                  for (int nt = 0; nt < 4; ++nt) { const bf16x8 btf = *(const bf16x8*)(Bt + (16 * nt + fr) * 72 + 32 * s + 8 * fq); hacc[nt][pl] = MFMA16(btf, xdf, hacc[nt][pl]); } }
          } }
        f32x4 gnv[2]; gnv[0] = *(const f32x4*)gnp; gnv[1] = *(const f32x4*)(gnp + 16);
        MEMFENCE();
        __syncthreads();
        if (mode != 1) {
#pragma unroll
        for (int it = 0; it < 4; ++it) { const int i = 16 * it + fr; float tot = 0.f;
#pragma unroll
            for (int ww = 0; ww < 8; ++ww) tot += ssp[ww * 64 + i];
            const float r = __builtin_amdgcn_rsqf(tot * (1.0f / 256.0f) + EPSN);
            if (t0 + i < L) {
#pragma unroll
                for (int pl = 0; pl < 2; ++pl) { const f32x4 q = vv[pl][it] * r * gnv[pl]; u32x2 ow; ow.x = cvt_pk_bf16(q[0], q[1]); ow.y = cvt_pk_bf16(q[2], q[3]);
                    *(u32x2*)(ob + (size_t)(row0 + t0 + i) * OCW + 256 * gi + 64 * hh + 16 * (2 * ph + pl) + 4 * fq) = ow; } }
        }
        }
    }
    { const int tid2 = otid(wv), w2 = tid2 >> 6, lane2 = tid2 & 63, fr2 = lane2 & 15, fq2 = lane2 >> 4, hh2 = w2 >> 1, ph2 = w2 & 1, head2 = 4 * gi + hh2;
      if (mode == 0) {
          float* so = P.out + O_SSS + ((size_t)(l * NSB + bi) * 16 + head2) * 4096;
#pragma unroll
          for (int nt = 0; nt < 4; ++nt)
#pragma unroll
              for (int pl = 0; pl < 2; ++pl) *(f32x4*)(so + (16 * (2 * ph2 + pl) + fr2) * 64 + 16 * nt + 4 * fq2) = hacc[nt][pl];
      } else if (mode == 1) {
          bf16_t* so = (bf16_t*)(P.ws + WS_SSDS) + ((size_t)(bi * 64 + c0) * 16 + head2) * 4096;
#pragma unroll
          for (int nt = 0; nt < 4; ++nt)
#pragma unroll
              for (int pl = 0; pl < 2; ++pl) { u32x2 hw; hw.x = cvt_pk_bf16(hacc[nt][pl][0], hacc[nt][pl][1]); hw.y = cvt_pk_bf16(hacc[nt][pl][2], hacc[nt][pl][3]);
                  *(u32x2*)(so + (16 * (2 * ph2 + pl) + fr2) * 64 + 16 * nt + 4 * fq2) = hw; }
      }
      if (sample || (mode == 2 && c0 == 63)) {
          float* co = sample ? P.out + O_SCB + (size_t)(l * NSB + bi) * 3 * 1536 : P.out + O_PCB + (size_t)(l * NB + g * GB + bi) * 3 * 1536;
          for (int idx = tid2; idx < 3 * 384; idx += 512) { const int r = idx / 384, ci = idx % 384;
              const int xc = ci < 256 ? 256 * gi + ci : (ci < 320 ? 1024 + 64 * gi + (ci - 256) : 1280 + 64 * gi + (ci - 320));
              co[r * 1536 + xc] = bf1(proj[(size_t)(row0 + L - 3 + r) * NPROJ + C_XBC + xc]); } } }
}

__device__ __forceinline__ void ssd_scan(int wv, const Params& P, int g, int l) {
    const int tid = otid(wv);
    unsigned* sb = (unsigned*)(P.ws + WS_SSDS); const float* acb = (const float*)(P.ws + WS_ACB);
    for (int e = blockIdx.x * 512 + tid; e < GB * 16 * 2048; e += gridDim.x * 512) {
        const int bi = e >> 15, head = (e >> 11) & 15, idx = e & 2047;
        unsigned* p0 = sb + ((size_t)(bi * 64) * 16 + head) * 2048 + idx; const float* a0 = acb + (bi * 64) * 16 + head;
        float H0 = 0.f, H1 = 0.f;
#pragma unroll 1
        for (int cb = 0; cb < 64; cb += 16) {
            unsigned S[16]; float A[16];
#pragma unroll
            for (int c = 0; c < 16; ++c) { S[c] = p0[(size_t)(cb + c) * 16 * 2048]; A[c] = a0[(cb + c) * 16]; }
            MEMFENCE();
#pragma unroll
            for (int c = 0; c < 16; ++c) { p0[(size_t)(cb + c) * 16 * 2048] = cvt_pk_bf16(H0, H1); H0 = A[c] * H0 + bflo(S[c]); H1 = A[c] * H1 + bfhi(S[c]); }
            MEMFENCE();
        }
        float* o = P.out + O_PSS + ((size_t)(l * NB + g * GB + bi) * 16 + head) * 4096 + 2 * idx; o[0] = H0; o[1] = H1;
    }
}

constexpr int LX_C = 0, LX_F = 17408, LH_O = 51200;
constexpr int LP_O = 84992;
__device__ __forceinline__ void lru_item(int wv, const Params& P, int g, int l, int item, int mode, unsigned char* lds) {
    const bool sample = (mode == 0);
    const int tid = otid(wv), w = tid >> 6, lane = tid & 63, fr = lane & 15, fq = lane >> 4;
    const int kp = item & 3, bi = sample ? item >> 2 : item >> 8, c0 = sample ? 0 : (item >> 2) & 63;
    const int row0 = sample ? MP + bi * SL : bi * SEQ, L = sample ? SL : SEQ;
    const int kb = 2 * kp + (w >> 2), ct = w & 3, c = 64 * kb + 16 * ct + fr, cl = c - 128 * kp;
    const bf16_t* proj = (const bf16_t*)(P.ws + WS_PROJ); bf16_t* oc = (bf16_t*)(P.ws + WS_OCAT) + OC_C;
    bf16_t* XC = (bf16_t*)(lds + LX_C); float* XCF = (float*)(lds + LX_F); float* HOUT = (float*)(lds + LH_O); float* POUT = (float*)(lds + LP_O);
    bf16x8 wrf[2], wif[2];
    { const u32x4* wf = (const u32x4*)(P.ws + WS_LWF) + (size_t)((l * 8 + kb) * 4 + ct) * 256 + lane;
      wrf[0] = as_bf8(wf[0]); wif[0] = as_bf8(wf[64]); wrf[1] = as_bf8(wf[128]); wif[1] = as_bf8(wf[192]); }
    const float br = P.in[I_BRG][l * 512 + c], bi_ = P.in[I_BIG][l * 512 + c], sp = softplusf_(-P.in[I_LAM][l * 512 + c]);
    float hstate = sample ? P.in[I_SLR][(size_t)(l * NSB + bi) * 512 + c] : 0.f, pstate = 1.f;
    const int cg8 = tid & 15, tp = tid >> 4, xch = 128 * kp + 8 * cg8;
    {
        const int t0 = c0 * 64;
        {
            float cw[4][8], acc[2][8];
            const float* cwp = P.in[I_CWC] + (size_t)l * 4 * 512 + xch; const float* cbp = P.in[I_CBC] + l * 512 + xch;
#pragma unroll
            for (int k = 0; k < 4; ++k) { const f32x4 a = *(const f32x4*)(cwp + k * 512), b = *(const f32x4*)(cwp + k * 512 + 4); cw[k][0] = a[0]; cw[k][1] = a[1]; cw[k][2] = a[2]; cw[k][3] = a[3]; cw[k][4] = b[0]; cw[k][5] = b[1]; cw[k][6] = b[2]; cw[k][7] = b[3]; }
            { const f32x4 a = *(const f32x4*)cbp, b = *(const f32x4*)(cbp + 4);
#pragma unroll
              for (int tk = 0; tk < 2; ++tk) { acc[tk][0] = a[0]; acc[tk][1] = a[1]; acc[tk][2] = a[2]; acc[tk][3] = a[3]; acc[tk][4] = b[0]; acc[tk][5] = b[1]; acc[tk][6] = b[2]; acc[tk][7] = b[3]; } }
#pragma unroll
            for (int r = 0; r < 5; ++r) {
                const int t = t0 + 2 * tp - 3 + r; float xv[8];
                if (t < 0) {
                    if (sample) { const float* sp2 = P.in[I_SCC] + ((size_t)(l * NSB + bi) * 3 + (3 + t)) * 512 + xch; const f32x4 a = *(const f32x4*)sp2, b = *(const f32x4*)(sp2 + 4);
                        xv[0] = a[0]; xv[1] = a[1]; xv[2] = a[2]; xv[3] = a[3]; xv[4] = b[0]; xv[5] = b[1]; xv[6] = b[2]; xv[7] = b[3]; }
                    else {
#pragma unroll
                        for (int e = 0; e < 8; ++e) xv[e] = 0.f; }
                } else { const int tl = t < L ? t : L - 1; unpack8(*(const u32x4*)(proj + (size_t)(row0 + tl) * NPROJ + C_XC + xch), xv); }
#pragma unroll
                for (int k = 0; k < 4; ++k) { const int tk = r - k; if (tk >= 0 && tk < 2) {
#pragma unroll
                    for (int e = 0; e < 8; ++e) acc[tk][e] += cw[k][e] * xv[e]; } }
            }
#pragma unroll
            for (int tk = 0; tk < 2; ++tk) { const int tok = 2 * tp + tk;
                *(u32x4*)(XC + tok * 136 + 8 * cg8) = pack8(acc[tk]);
                *(f32x4*)(XCF + tok * 132 + 8 * cg8) = (f32x4){acc[tk][0], acc[tk][1], acc[tk][2], acc[tk][3]}; *(f32x4*)(XCF + tok * 132 + 8 * cg8 + 4) = (f32x4){acc[tk][4], acc[tk][5], acc[tk][6], acc[tk][7]}; }
        }
        __syncthreads();
#pragma unroll
        for (int tt = 0; tt < 4; ++tt) {
            const bf16x8 a0 = *(const bf16x8*)(XC + (16 * tt + fr) * 136 + 64 * (w >> 2) + 8 * fq), a1 = *(const bf16x8*)(XC + (16 * tt + fr) * 136 + 64 * (w >> 2) + 32 + 8 * fq);
            f32x4 ar = MFMA16(a0, wrf[0], ((f32x4){0.f, 0.f, 0.f, 0.f})); ar = MFMA16(a1, wrf[1], ar);
            f32x4 ai = MFMA16(a0, wif[0], ((f32x4){0.f, 0.f, 0.f, 0.f})); ai = MFMA16(a1, wif[1], ai);
            float as_[4], bs_[4]; float A = 1.f, B = 0.f;
#pragma unroll
            for (int jj = 0; jj < 4; ++jj) { const int tok = 16 * tt + 4 * fq + jj; const float xf = XCF[tok * 132 + cl];
                const float r = sigmoidf_(ar[jj] + br), ig = sigmoidf_(ai[jj] + bi_); const float la = -8.0f * r * sp; float a = __expf(la); const float x2 = 2.0f * la; float mult = __builtin_amdgcn_sqrtf(x2 > -0.05f ? -x2 * (1.0f + x2 * (0.5f + x2 * 0.16666667f)) : 1.0f - a * a);
                if (!sample && t0 + tok == 0) mult = 1.0f;
                float bt = mult * ig * xf; if (t0 + tok >= L) { a = 1.f; bt = 0.f; }
                B = a * B + bt; A = A * a; as_[jj] = A; bs_[jj] = B; }
            float carry = hstate, mycarry = 0.f, pcarry = pstate, mypc = 1.f;
#pragma unroll
            for (int k = 0; k < 4; ++k) { const float Ak = bperm(A, fr + 16 * k), Bk = bperm(B, fr + 16 * k); if (k == fq) { mycarry = carry; mypc = pcarry; } carry = Ak * carry + Bk; pcarry = Ak * pcarry; }
            hstate = carry; pstate = pcarry;
#pragma unroll
            for (int jj = 0; jj < 4; ++jj) { HOUT[(16 * tt + 4 * fq + jj) * 132 + cl] = bs_[jj] + as_[jj] * mycarry; if (mode == 1) POUT[(16 * tt + 4 * fq + jj) * 132 + cl] = as_[jj] * mypc; }
        }
        __syncthreads();
#pragma unroll
        for (int tk = 0; tk < 2; ++tk) { const int tok = 2 * tp + tk, t = t0 + tok;
            if (t < L) { const f32x4 h0 = *(const f32x4*)(HOUT + tok * 132 + 8 * cg8), h1 = *(const f32x4*)(HOUT + tok * 132 + 8 * cg8 + 4);
                if (mode == 1) {
                    bf16_t* hz = (bf16_t*)(P.ws + WS_HZ) + (size_t)(row0 + t) * 512 + xch; bf16_t* pz = (bf16_t*)(P.ws + WS_PZ) + (size_t)(row0 + t) * 512 + xch;
                    const f32x4 q0 = *(const f32x4*)(POUT + tok * 132 + 8 * cg8), q1 = *(const f32x4*)(POUT + tok * 132 + 8 * cg8 + 4);
                    u32x4 hw; hw.x = cvt_pk_bf16(h0[0], h0[1]); hw.y = cvt_pk_bf16(h0[2], h0[3]); hw.z = cvt_pk_bf16(h1[0], h1[1]); hw.w = cvt_pk_bf16(h1[2], h1[3]); *(u32x4*)hz = hw;
                    u32x4 pw; pw.x = cvt_pk_bf16(q0[0], q0[1]); pw.y = cvt_pk_bf16(q0[2], q0[3]); pw.z = cvt_pk_bf16(q1[0], q1[1]); pw.w = cvt_pk_bf16(q1[2], q1[3]); *(u32x4*)pz = pw;
                } else {
                float gf[8]; unpack8(*(const u32x4*)(proj + (size_t)(row0 + t) * NPROJ + C_GC + xch), gf);
                u32x4 ow; ow.x = cvt_pk_bf16(h0[0] * siluf_(gf[0]), h0[1] * siluf_(gf[1])); ow.y = cvt_pk_bf16(h0[2] * siluf_(gf[2]), h0[3] * siluf_(gf[3]));
                ow.z = cvt_pk_bf16(h1[0] * siluf_(gf[4]), h1[1] * siluf_(gf[5])); ow.w = cvt_pk_bf16(h1[2] * siluf_(gf[6]), h1[3] * siluf_(gf[7]));
                *(u32x4*)(oc + (size_t)(row0 + t) * OCW + xch) = ow; } } }
    }
    if (mode == 1) {
        if (fq == 0) { ((float*)(P.ws + WS_LCA))[(size_t)(bi * 64 + c0) * 512 + c] = pstate; ((float*)(P.ws + WS_LCB))[(size_t)(bi * 64 + c0) * 512 + c] = hstate; }
    } else {
      float* lo = P.out + O_SLR + (size_t)(l * NSB + bi) * 512;
      if (fq == 0) lo[c] = hstate;
      float* co = P.out + O_SCC + (size_t)(l * NSB + bi) * 3 * 512;
      if (tid < 384) { const int r = tid >> 7, ci = tid & 127; co[r * 512 + 128 * kp + ci] = bf1(proj[(size_t)(row0 + L - 3 + r) * NPROJ + C_XC + 128 * kp + ci]); } }
    __syncthreads();
}

__device__ __forceinline__ void lru_scan(int wv, const Params& P, int g, int l) {
    const int tid = otid(wv); const int e = blockIdx.x * 512 + tid;
    const float* lca = (const float*)(P.ws + WS_LCA); float* lcb = (float*)(P.ws + WS_LCB); const bf16_t* proj = (const bf16_t*)(P.ws + WS_PROJ);
    if (e < GB * 512) {
        const int bi = e >> 9, chn = e & 511; float carry = 0.f;
#pragma unroll 1
        for (int cb = 0; cb < 64; cb += 16) {
            float A[16], B[16];
#pragma unroll
            for (int c = 0; c < 16; ++c) { const size_t o = (size_t)(bi * 64 + cb + c) * 512 + chn; A[c] = lca[o]; B[c] = lcb[o]; }
            MEMFENCE();
#pragma unroll
            for (int c = 0; c < 16; ++c) { lcb[(size_t)(bi * 64 + cb + c) * 512 + chn] = carry; carry = A[c] * carry + B[c]; }
            MEMFENCE();
        }
        P.out[O_PLR + (size_t)(l * NB + g * GB + bi) * 512 + chn] = carry;
    } else if (e < GB * 512 + GB * 3 * 512) {
        const int q = e - GB * 512, bi = q / 1536, r = (q % 1536) >> 9, chn = q & 511;
        P.out[O_PCC + ((size_t)(l * NB + g * GB + bi) * 3 + r) * 512 + chn] = bf1(proj[(size_t)(bi * SEQ + SEQ - 3 + r) * NPROJ + C_XC + chn]);
    }
}
__device__ __forceinline__ void lru_apply(int wv, const Params& P) {
    const int tid = otid(wv);
    const bf16_t* hzb = (const bf16_t*)(P.ws + WS_HZ); const bf16_t* pzb = (const bf16_t*)(P.ws + WS_PZ); const float* lcb = (const float*)(P.ws + WS_LCB);
    const bf16_t* proj = (const bf16_t*)(P.ws + WS_PROJ); bf16_t* oc = (bf16_t*)(P.ws + WS_OCAT) + OC_C;
    for (int u = blockIdx.x * 512 + tid; u < MP * 64; u += gridDim.x * 512) {
        const int row = u >> 6, cg = u & 63; const size_t o = (size_t)row * 512 + 8 * cg;
        float hf[8], pf8[8]; unpack8(*(const u32x4*)(hzb + o), hf); unpack8(*(const u32x4*)(pzb + o), pf8);
        const f32x4 h0 = (f32x4){hf[0], hf[1], hf[2], hf[3]}, h1 = (f32x4){hf[4], hf[5], hf[6], hf[7]}, p0 = (f32x4){pf8[0], pf8[1], pf8[2], pf8[3]}, p1 = (f32x4){pf8[4], pf8[5], pf8[6], pf8[7]};
        const float* cp = lcb + (size_t)(row >> 6) * 512 + 8 * cg; const f32x4 c0 = *(const f32x4*)cp, c1 = *(const f32x4*)(cp + 4);
        float gf[8]; unpack8(*(const u32x4*)(proj + (size_t)row * NPROJ + C_GC + 8 * cg), gf);
        const f32x4 a = h0 + p0 * c0, b = h1 + p1 * c1;
        u32x4 ow; ow.x = cvt_pk_bf16(a[0] * siluf_(gf[0]), a[1] * siluf_(gf[1])); ow.y = cvt_pk_bf16(a[2] * siluf_(gf[2]), a[3] * siluf_(gf[3]));
        ow.z = cvt_pk_bf16(b[0] * siluf_(gf[4]), b[1] * siluf_(gf[5])); ow.w = cvt_pk_bf16(b[2] * siluf_(gf[6]), b[3] * siluf_(gf[7]));
        *(u32x4*)(oc + (size_t)row * OCW + 8 * cg) = ow;
    }
}

__device__ __forceinline__ void phase_mix1(int wv, const Params& P, int g, int l, unsigned char* lds, bool with_smp, int rep = 0) {
    unsigned* ctr = (unsigned*)(P.ws + WS_CTR) + (g * 2 + l) * 16 + rep * 4;
    int* slot = (int*)(lds + 163776);
    const int n_att = GB * 64, n_smp = with_smp ? (8 + 32 + 32) : 0, n_ssd = GB * 64 * 4, n_lru = GB * 64 * 4;
    const int total = n_att + n_smp + n_ssd + n_lru;
    for (;;) {
        __syncthreads();
        if (otid(wv) == 0) *slot = (int)atomicAdd(ctr, 1u);
        __syncthreads();
        int it = *slot;
        if (it >= total) break;
#ifdef PROBE_ATT2
        if (it < n_att) { attn_item(wv, P, g, l, ((it & 63) ^ 63) | (it & ~63), false, lds); __syncthreads(); attn_item(wv, P, g, l, ((it & 63) ^ 63) | (it & ~63), false, lds); continue; }
#endif
        if (it < n_att) { attn_item(wv, P, g, l, ((it & 63) ^ 63) | (it & ~63), false, lds); continue; }
        it -= n_att;
        if (with_smp) {
            if (it < 8) { attn_item(wv, P, g, l, it, true, lds); continue; }
            it -= 8;
            if (it < 32) { ssd_item(wv, P, g, l, it, 0, lds); continue; }
            it -= 32;
            if (it < 32) { lru_item(wv, P, g, l, it, 0, lds); continue; }
            it -= 32;
        }
#ifdef PROBE_SSDA2
        if (it < n_ssd) { ssd_item(wv, P, g, l, it, 1, lds); ssd_item(wv, P, g, l, it, 1, lds); continue; }
#endif
        if (it < n_ssd) { ssd_item(wv, P, g, l, it, 1, lds); continue; }
        it -= n_ssd;
#ifdef PROBE_LRUA2
        lru_item(wv, P, g, l, it, 1, lds); __syncthreads();
#endif
        lru_item(wv, P, g, l, it, 1, lds);
    }
}
__device__ __forceinline__ void phase_smpmix(int wv, const Params& P, int l, unsigned char* lds) {
    unsigned* ctr = (unsigned*)(P.ws + WS_CTR) + l * 16 + 12;
    int* slot = (int*)(lds + 163776);
    for (;;) {
        __syncthreads();
        if (otid(wv) == 0) *slot = (int)atomicAdd(ctr, 1u);
        __syncthreads();
        int it = *slot;
        if (it >= 72) break;
        if (it < 8) { attn_item(wv, P, 0, l, it, true, lds); continue; }
        it -= 8;
        if (it < 32) { ssd_item(wv, P, 0, l, it, 0, lds); continue; }
        it -= 32;
        lru_item(wv, P, 0, l, it, 0, lds);
    }
}
__device__ __forceinline__ void phase_mix3(int wv, const Params& P, int g, int l, unsigned char* lds, int rep = 0) {
    for (int it = (int)blockIdx.x; it < GB * 64 * 4; it += (int)gridDim.x) { __syncthreads(); ssd_item(wv, P, g, l, it, 2, lds); }
    __syncthreads();
    lru_apply(wv, P);
}

struct SampleOrder { int idx, n;
    __device__ __forceinline__ bool next(int i, Unit& u) const { if (i != 0 || idx < 0 || idx >= n) return false; u.pm = MP / BM; u.pn = idx; return true; }
    __device__ __forceinline__ void a_ready(const Unit&) const {}
    __device__ __forceinline__ void done(const Unit&) const {} };

template <class Sched> __device__ __forceinline__ void st_p1(int wv, PG8_LAS unsigned char* glds, const Sched& S, int g, int l) {
    const Params P = load_params(); float* ssn = (float*)(P.ws + WS_SS) + (size_t)(g * 4 + l * 2 + 0) * MLOC;
    Gemm gm{(const bf16_t*)(P.ws + WS_HBUF), (const bf16_t*)(P.ws + WS_WIN) + (size_t)l * NWIN * 1024, MP, NWIN, 1024, wv};
    EpiIn E{(bf16_t*)(P.ws + WS_PROJ), (float*)(P.ws + WS_DT), ssn};
    GEMMCALL<EpiIn, Sched, false>(glds, gm, S, E, nullptr);
}
template <class Sched> __device__ __forceinline__ void st_p3m(int wv, PG8_LAS unsigned char* glds, const Sched& S, int l) {
    const Params P = load_params(); bf16_t* proj = (bf16_t*)(P.ws + WS_PROJ);
    Gemm gm{(const bf16_t*)(P.ws + WS_OCAT), (const bf16_t*)(P.ws + WS_WCAT) + (size_t)l * 1024 * 2048, MP, 1024, 2048, wv};
    EpiMergeF E{proj + C_GM, (bf16_t*)(P.ws + WS_MIXB)}; GEMMCALL<EpiMergeF, Sched, false>(glds, gm, S, E, nullptr);
}
template <class Sched> __device__ __forceinline__ void st_pp(int wv, PG8_LAS unsigned char* glds, const Sched& S, int l) {
    const Params P = load_params();
    Gemm gm{(const bf16_t*)(P.ws + WS_PBUF) + (size_t)l * MLOC * 256, (const bf16_t*)(P.ws + WS_WPP) + (size_t)l * 1024 * 256, MP, 1024, 256, wv};
    EpiPP E{(bf16_t*)(P.ws + WS_PP)}; GEMMCALL<EpiPP, Sched, false>(glds, gm, S, E, nullptr);
}
template <class Sched> __device__ __forceinline__ void st_p3(int wv, PG8_LAS unsigned char* glds, const Sched& S, int l) { st_p3m(wv, glds, S, l); st_pp(wv, glds, S, l); }
struct TailOrder { int c;
    __device__ __forceinline__ bool next(int i, Unit& u) const { if (c < 0 || i >= 4) return false; const int idx = c + 64 * i; u.pm = idx >> 2; u.pn = idx & 3; return true; }
    __device__ __forceinline__ void a_ready(const Unit&) const {}
    __device__ __forceinline__ void done(const Unit&) const {} };
template <class Sched> __device__ __forceinline__ void st_p4(int wv, PG8_LAS unsigned char* glds, const Sched& S, int g, int l) {
    const Params P = load_params(); float* ssp = (float*)(P.ws + WS_SS) + (size_t)(g * 4 + l * 2 + 1) * MLOC;
    Gemm gm{(const bf16_t*)(P.ws + WS_MIXB), (const bf16_t*)(P.ws + WS_WOUT) + (size_t)l * 1024 * 1024, MP, 1024, 1024, wv};
    const float* xa = P.in[I_XP] + (size_t)g * MP * DM; const float* xb = P.in[I_XS];
    EpiOut E{xa, xb, (bf16_t*)(P.ws + WS_XRES), (bf16_t*)(P.ws + WS_UBUF), P.in[I_PNG] + l * 1024, ssp, l == 0 ? 1 : 0};
    GEMMCALL<EpiOut, Sched, false>(glds, gm, S, E, nullptr);
}
template <class Sched> __device__ __forceinline__ void st_p6(int wv, PG8_LAS unsigned char* glds, const Sched& S, int g, int l) {
    const Params P = load_params(); float* ssp = (float*)(P.ws + WS_SS) + (size_t)(g * 4 + l * 2 + 1) * MLOC;
    Gemm gm{(const bf16_t*)(P.ws + WS_UBUF), (const bf16_t*)(P.ws + WS_WPG) + (size_t)l * 1024 * 1024, MP, 1024, 1024, wv};
    float* ya = P.out + O_YP + (size_t)g * MP * DM; float* yb = P.out + O_YS;
    EpiGate E{ya, yb, (const bf16_t*)(P.ws + WS_PP), ssp, (l == 0) ? (bf16_t*)(P.ws + WS_HBUF) : nullptr, P.in[I_NG] + 1024, (float*)(P.ws + WS_SS) + (size_t)(g * 4 + 2) * MLOC, (bf16_t*)(P.ws + WS_XRES)};
    GEMMCALL<EpiGate, Sched, false>(glds, gm, S, E, nullptr);
}

__global__ void __launch_bounds__(512) fwd_megakernel(Params Parg) {
    extern __shared__ __attribute__((aligned(16))) unsigned char shm[];
    cg::grid_group grid = cg::this_grid();
    PG8_LAS unsigned char* glds = (PG8_LAS unsigned char*)shm;
    const int G = (int)gridDim.x, cidx = (int)blockIdx.x; const int wv = __builtin_amdgcn_readfirstlane((int)(threadIdx.x >> 6));
    volatile unsigned* bst = (volatile unsigned*)(shm + 163792);
    if (otid(wv) == 0) { bst[0] = 0u; bst[1] = 0u; }
    __syncthreads();
    { const Params P = load_params(); phase_weights(wv, P, shm); }
    { const Params P = load_params(); phase_prep(wv, P, 0); }
    grid.sync();
    { const Params P = load_params(); if (otid(wv) == 0) (void)xb_add(&((unsigned*)(P.ws + WS_BAR))[XB_XCNT(xb_xcc_id())], 1u); }
#ifdef PROBE_T
    unsigned long long tacc = 0, tbeg = 0;
#define TBEG(k) do { if (PROBE_T == (k)) tbeg = __builtin_amdgcn_s_memrealtime(); } while (0)
#define TEND(k) do { if (PROBE_T == (k)) tacc += __builtin_amdgcn_s_memrealtime() - tbeg; } while (0)
#else
#define TBEG(k) do {} while (0)
#define TEND(k) do {} while (0)
#endif
#define GSYNC() do { TBEG(1); const Params Pb = load_params(); xcd_sync(wv, (unsigned*)(Pb.ws + WS_BAR), bst); TEND(1); } while (0)
#pragma unroll 1
    for (int g = 0; g < NG; ++g) {
#pragma unroll 1
        for (int l = 0; l < 2; ++l) {
            const int key = g * 2 + l;
            { StaticOrder S; S.init(MP, NWIN, G, cidx); st_p1(wv, glds, S, g, l); }
            if (G == 256) { TailOrder To{cidx - 192}; st_pp(wv, glds, To, l); }
            const int coff = (G > 226) ? 192 : 0;
            if (key == 0) { SampleOrder So{cidx - coff, 35}; st_p1(wv, glds, So, 0, 0); }
            if (key == 1) { SampleOrder So{cidx - coff, 4}; st_p6(wv, glds, So, 0, 0); }
            if (key == 2) { SampleOrder So{cidx - coff, 4}; st_p4(wv, glds, So, 0, 1); }
            GSYNC();
            if (key == 1) { SampleOrder So{cidx, 35}; st_p1(wv, glds, So, 0, 1); }
            if (key == 2) { SampleOrder So{cidx, 4}; st_p6(wv, glds, So, 0, 1); }
            { const Params P = load_params(); phase_mix1(wv, P, g, l, shm, key == 0); }
            GSYNC();
            if (key == 0) { SampleOrder So{cidx, 4}; st_p3(wv, glds, So, 0); }
            if (key == 1) { const Params P = load_params(); phase_smpmix(wv, P, 1, shm); }
            TBEG(3); { const Params P = load_params(); ssd_scan(wv, P, g, l); lru_scan(wv, P, g, l); } TEND(3);
            GSYNC();
            if (key == 0) { SampleOrder So{cidx, 4}; st_p4(wv, glds, So, 0, 0); }
            if (key == 1) { SampleOrder So{cidx, 4}; st_p3(wv, glds, So, 1); }
            { const Params P = load_params(); phase_mix3(wv, P, g, l, shm); }
            GSYNC();
            TBEG(4); { StaticOrder S; S.init(MP, 1024, G, cidx); if (G == 256) st_p3m(wv, glds, S, l); else st_p3(wv, glds, S, l); } TEND(4);
            GSYNC();
            TBEG(2); { StaticOrder S; S.init(MP, 1024, G, cidx); st_p4(wv, glds, S, g, l); } TEND(2);
            GSYNC();
            TBEG(2); { StaticOrder S; S.init(MP, 1024, G, cidx); st_p6(wv, glds, S, g, l); } TEND(2);
            if (l == 1 && g + 1 < NG) { const Params P = load_params(); phase_prep(wv, P, g + 1); }
            GSYNC();
        }
    }
#ifdef PROBE_T
    if (blockIdx.x == 0 && otid(wv) == 0) { const Params P = load_params(); P.out[O_YP + 5] += (float)tacc * 1e-4f; }
#endif
}


constexpr int LDS_BYTES = 163840;

extern "C" void kernel_launch(void* const* d_in, const int* in_sizes, int n_in, void* d_out, int out_size, void* d_ws, size_t ws_size, hipStream_t stream) {
    static int grid_blocks = 0;
    if (grid_blocks == 0) {
        if (n_in != 35 || (size_t)out_size != O_END || ws_size < WS_END) { fprintf(stderr, "kernel_launch: unexpected shapes: n_in %d out %d ws %zu (need %zu)\n", n_in, out_size, ws_size, (size_t)WS_END); grid_blocks = -1; return; }
        int dev = 0, cus = 0, per_cu = 0;
        hipGetDevice(&dev); hipDeviceGetAttribute(&cus, hipDeviceAttributeMultiprocessorCount, dev);
        if (hipFuncSetAttribute((const void*)fwd_megakernel, hipFuncAttributeMaxDynamicSharedMemorySize, LDS_BYTES) != hipSuccess) { fprintf(stderr, "kernel_launch: hipFuncSetAttribute failed\n"); grid_blocks = -1; return; }
        if (hipOccupancyMaxActiveBlocksPerMultiprocessor(&per_cu, (const void*)fwd_megakernel, 512, LDS_BYTES) != hipSuccess || per_cu < 1) { fprintf(stderr, "kernel_launch: occupancy query gives %d\n", per_cu); per_cu = 1; }
        (void)hipGetLastError();
        grid_blocks = cus;
        if (grid_blocks < 35) { fprintf(stderr, "kernel_launch: this kernel needs at least 35 workgroups (device reports %d CUs)\n", cus); grid_blocks = -1; return; }
    }
    if (grid_blocks < 0) return;
    Params p{};
    for (int i = 0; i < 35; ++i) p.in[i] = (const float*)d_in[i];
    p.out = (float*)d_out; p.ws = (unsigned char*)d_ws;
    void* args[] = {&p};
    hipError_t e = hipLaunchCooperativeKernel((const void*)fwd_megakernel, dim3(grid_blocks), dim3(512), args, LDS_BYTES, stream);
    if (e != hipSuccess) fprintf(stderr, "cooperative launch failed: %s (grid %d)\n", hipGetErrorString(e), grid_blocks);
}
```

```cpp
#include <hip/hip_runtime.h>
#include <hip/hip_cooperative_groups.h>
#include <cstdio>
namespace cg = cooperative_groups;
namespace pg8 {
#define PG8_LAS __attribute__((address_space(3)))
typedef unsigned short bf16_t;
typedef short bf16x8 __attribute__((ext_vector_type(8)));
typedef float f32x4 __attribute__((ext_vector_type(4)));
typedef unsigned u32x4 __attribute__((ext_vector_type(4)));
constexpr int BM = 256, BK = 64, HALF = 128, HTB = HALF * BK * 2  , STAGE_BYTES = 8 * HTB, NXCD = 8, WGM = 8;

__host__ __device__ __forceinline__ int lds_byte(int r, int c) { const int st = (r >> 4) * 2 + (c >> 5), rr = r & 15, cc = c & 31, ob = rr * 64 + cc * 2; return st * 1024 + (ob ^ (((ob >> 9) & 1) << 5)); }
__host__ __device__ __forceinline__ void stage_rc(int b, int& R, int& C) { const int st = b / 1024, sb = b % 1024, swz = sb ^ (((sb >> 9) & 1) << 5); R = (st >> 1) * 16 + swz / 64; C = (st & 1) * 32 + (swz % 64) / 2; }
__host__ __device__ __forceinline__ int perm32(int rho) { const int n = rho >> 4, i = rho & 15; return 8 * (i >> 2) + 4 * n + (i & 3); }

struct Unit { int pm, pn; };
struct Gemm { const bf16_t* A; const bf16_t* Bt; int M, N, K, wv; };
struct StaticOrder {
    int nM, nN, nwg, G, c;
    __host__ __device__ void init(int M, int N, int G_, int c_) { nM = M / BM; nN = N / BM; nwg = nM * nN; G = G_; c = c_; }
    __host__ __device__ bool next(int i, Unit& u) const {
        const long L = (long)i * G + c; if (L >= nwg) return false;
        int wgid = (int)L; { const int q = nwg / NXCD, r = nwg % NXCD, xcd = wgid % NXCD, off = wgid / NXCD; wgid = (xcd < r ? xcd * (q + 1) : r * (q + 1) + (xcd - r) * q) + off; }
        const int nig = WGM * nN, gid = wgid / nig, fm = gid * WGM, gsz = (nM - fm) < WGM ? (nM - fm) : WGM;
        u.pm = fm + ((wgid % nig) % gsz); u.pn = (wgid % nig) / gsz; return true;
    }
    __device__ __forceinline__ void a_ready(const Unit&) const {}
    __device__ __forceinline__ void done(const Unit&) const {}
};
__device__ __forceinline__ unsigned cvt_pk_bf16(float lo, float hi) { unsigned r; asm volatile("v_cvt_pk_bf16_f32 %0, %1, %2" : "=v"(r) : "v"(lo), "v"(hi)); return r; }
template <class Epi, class Sched, bool STAMP = false>
__device__ __forceinline__ void gemm_phase(PG8_LAS unsigned char* lds, const Gemm g, const Sched& S, const Epi& E, unsigned long long* stamps) {
    int tid_; asm volatile("v_mbcnt_lo_u32_b32 %0, -1, 0\n\tv_mbcnt_hi_u32_b32 %0, -1, %0" : "=v"(tid_)); tid_ += g.wv * 64; const int tid = tid_, wid = __builtin_amdgcn_readfirstlane(tid >> 6), lane = tid & 63, wr = wid >> 2, wc = wid & 3, fr = lane & 15, fq = lane >> 4;
    const int K = g.K, nt = K / BK;
    int ts_lo = 0, ts_hi = 0, nts = 0; const unsigned long long rt_entry = STAMP ? (unsigned long long)wall_clock64() : 0ull;
#define PG8_STAMP() do { if (STAMP && wid == 0 && nts < 64) { const unsigned long long _c = (unsigned long long)clock64(); \
        ts_lo = (lane == nts) ? (int)(unsigned)_c : ts_lo; ts_hi = (lane == nts) ? (int)(unsigned)(_c >> 32) : ts_hi; ++nts; } } while (0)
    PG8_STAMP();
    unsigned voffA[2], voffB[2];
#pragma unroll
    for (int i = 0; i < 2; ++i) { int R, C; stage_rc(tid * 16 + i * 8192, R, C); const int Rb = Epi::PERM ? ((R & ~31) + perm32(R & 31)) : R;
        voffA[i] = (unsigned)(R * K + C) * 2u; voffB[i] = (unsigned)(Rb * K + C) * 2u; }
    const size_t kstep = (size_t)(BK * 2);
    const size_t hstep = (size_t)HALF * K * 2;
    const size_t tstep = 2 * hstep;
    const unsigned ldsw = (unsigned)wid * 1024u;
    const int aoff = lds_byte(wr * 64 + fr, fq * 8), boff = lds_byte(wc * 32 + fr, fq * 8);
#define PG8_SA(b, h) (((b) * 2 + (h)) * HTB)
#define PG8_SB(b, h) ((4 + (b) * 2 + (h)) * HTB)
#define PG8_STAGE(bufoff, gbase, voff) do { _Pragma("unroll") for (int _i = 0; _i < 2; ++_i) \
        __builtin_amdgcn_global_load_lds((const unsigned*)((const char*)(gbase) + (voff)[_i]), (PG8_LAS unsigned*)(lds + (bufoff) + ldsw + _i * 8192), 16, 0, 0); } while (0)
#define PG8_LDA(dst, b, h) do { _Pragma("unroll") for (int m = 0; m < 4; ++m) _Pragma("unroll") for (int k = 0; k < 2; ++k) dst[m][k] = *(const PG8_LAS bf16x8*)(lds + PG8_SA(b, h) + aoff + m * 2048 + k * 1024); } while (0)
#define PG8_LDB(dst, b, h) do { _Pragma("unroll") for (int n = 0; n < 2; ++n) _Pragma("unroll") for (int k = 0; k < 2; ++k) dst[n][k] = *(const PG8_LAS bf16x8*)(lds + PG8_SB(b, h) + boff + n * 2048 + k * 1024); } while (0)
#define PG8_MMA(ai, bj, At, Bt) do { __builtin_amdgcn_s_setprio(1); _Pragma("unroll") for (int m = 0; m < 4; ++m) _Pragma("unroll") for (int n = 0; n < 2; ++n) _Pragma("unroll") for (int k = 0; k < 2; ++k) \
        acc[ai][bj][m][n] = __builtin_amdgcn_mfma_f32_16x16x32_bf16(Bt[n][k], At[m][k], acc[ai][bj][m][n], 0, 0, 0); __builtin_amdgcn_s_setprio(0); } while (0)
#define PG8_WAIT_V(n) asm volatile("s_waitcnt vmcnt(" #n ")" ::: "memory")
#define PG8_WAIT_L(n) asm volatile("s_waitcnt lgkmcnt(" #n ")" ::: "memory")
#define PG8_BAR __builtin_amdgcn_s_barrier()
#define PG8_SCHED __builtin_amdgcn_sched_barrier(0)
    Unit cur, nxt; int ui = 0;
    if (!S.next(0, cur)) return;
    f32x4 acc[2][2][4][2];
#pragma unroll
    for (int a = 0; a < 2; ++a)
#pragma unroll
        for (int b = 0; b < 2; ++b)
#pragma unroll
            for (int m = 0; m < 4; ++m)
#pragma unroll
                for (int n = 0; n < 2; ++n) acc[a][b][m][n] = (f32x4){0.f, 0.f, 0.f, 0.f};
    bf16x8 At[4][2], B0[2][2], B1[2][2];
    const char* cA = (const char*)g.A + (size_t)cur.pm * tstep; const char* cB = (const char*)g.Bt + (size_t)cur.pn * tstep;
    S.a_ready(cur);
    PG8_STAGE(PG8_SB(0, 0), cB, voffB); PG8_STAGE(PG8_SA(0, 0), cA, voffA); PG8_STAGE(PG8_SB(0, 1), cB + hstep, voffB); PG8_STAGE(PG8_SA(0, 1), cA + hstep, voffA);
    if (wr == 1) PG8_BAR;
    PG8_WAIT_V(4); PG8_BAR;
    PG8_STAGE(PG8_SB(1, 0), cB + kstep, voffB); PG8_STAGE(PG8_SA(1, 0), cA + kstep, voffA); PG8_STAGE(PG8_SB(1, 1), cB + hstep + kstep, voffB);
    PG8_WAIT_V(6); PG8_BAR;
    PG8_STAMP();
    for (;;) {
        const bool has_next = S.next(ui + 1, nxt);
        const char* nA = has_next ? (const char*)g.A + (size_t)nxt.pm * tstep : cA; const char* nB = has_next ? (const char*)g.Bt + (size_t)nxt.pn * tstep : cB;
        for (int t = 0; t < nt; t += 2) {
            if constexpr (Epi::HAS_MID) { if (t == Epi::T1 || t == Epi::T2) E.mid(acc, cur, t, wr, wc, fr, fq); }
            const bool last = (t == nt - 2);
            const char* a1 = cA + (size_t)(t + 1) * kstep;
            const char* a2 = last ? nA : cA + (size_t)(t + 2) * kstep; const char* b2 = last ? nB : cB + (size_t)(t + 2) * kstep;
            const char* a3 = a2 + kstep; const char* b3 = b2 + kstep;
            if (last && has_next) S.a_ready(nxt);
            PG8_LDB(B0, 0, 0); PG8_SCHED; PG8_LDA(At, 0, 0); PG8_STAGE(PG8_SA(1, 1), a1 + hstep, voffA);
            PG8_WAIT_L(8); PG8_BAR; PG8_WAIT_L(0); PG8_MMA(0, 0, At, B0); PG8_BAR; PG8_SCHED;
            PG8_LDB(B1, 0, 1); PG8_STAGE(PG8_SB(0, 0), b2, voffB);
            PG8_BAR; PG8_WAIT_L(0); PG8_MMA(0, 1, At, B1); PG8_BAR;
            PG8_LDA(At, 0, 1); PG8_STAGE(PG8_SA(0, 0), a2, voffA);
            PG8_BAR; PG8_WAIT_L(0); PG8_MMA(1, 0, At, B0); PG8_BAR; PG8_SCHED;
            PG8_STAGE(PG8_SB(0, 1), b2 + hstep, voffB);
            PG8_WAIT_V(6); PG8_BAR; PG8_MMA(1, 1, At, B1); PG8_BAR;
            PG8_LDB(B0, 1, 0); PG8_SCHED; PG8_LDA(At, 1, 0); PG8_STAGE(PG8_SA(0, 1), a2 + hstep, voffA);
            PG8_WAIT_L(8); PG8_BAR; PG8_WAIT_L(0); PG8_MMA(0, 0, At, B0); PG8_BAR; PG8_SCHED;
            PG8_LDB(B1, 1, 1); PG8_STAGE(PG8_SB(1, 0), b3, voffB);
            PG8_BAR; PG8_WAIT_L(0); PG8_MMA(0, 1, At, B1); PG8_BAR;
            PG8_LDA(At, 1, 1); PG8_STAGE(PG8_SA(1, 0), a3, voffA);
            PG8_BAR; PG8_WAIT_L(0); PG8_MMA(1, 0, At, B0); PG8_BAR; PG8_SCHED;
            PG8_STAGE(PG8_SB(1, 1), b3 + hstep, voffB);
            PG8_WAIT_V(6); PG8_BAR; PG8_MMA(1, 1, At, B1); PG8_BAR;
        }
        PG8_STAMP();
        if constexpr (!Epi::AFTER_DRAIN) { E(acc, cur, wr, wc, fr, fq); S.done(cur); }
        PG8_STAMP();
        if (!has_next) break;
#pragma unroll
        for (int a = 0; a < 2; ++a)
#pragma unroll
            for (int b = 0; b < 2; ++b)
#pragma unroll
                for (int m = 0; m < 4; ++m)
#pragma unroll
                    for (int n = 0; n < 2; ++n) acc[a][b][m][n] = (f32x4){0.f, 0.f, 0.f, 0.f};
        cur = nxt; cA = nA; cB = nB; ++ui;
    }
    PG8_WAIT_V(0);
    if (wr == 0) PG8_BAR;
    PG8_BAR;
    if constexpr (Epi::AFTER_DRAIN) { E.fused(acc, cur, wr, wc, fr, fq, lds, wid, lane); S.done(cur); }
    PG8_STAMP();
    if (STAMP && wid == 0) { stamps[lane] = lane < nts ? (((unsigned long long)(unsigned)ts_hi << 32) | (unsigned)ts_lo) : 0ull;
        if (lane == 62) stamps[62] = rt_entry; if (lane == 63) stamps[63] = (unsigned long long)wall_clock64(); }
#undef PG8_STAMP
#undef PG8_SA
#undef PG8_SB
#undef PG8_STAGE
#undef PG8_LDA
#undef PG8_LDB
#undef PG8_MMA
#undef PG8_WAIT_V
#undef PG8_WAIT_L
#undef PG8_BAR
#undef PG8_SCHED
}
}
using namespace pg8;
#ifndef EPI_MASK
#define EPI_MASK 31
#endif
#define GEMMCALL gemm_sel
template <class Epi, class Sched, bool X> __device__ __forceinline__ void gemm_sel(PG8_LAS unsigned char* lds, const Gemm g, const Sched& S, const Epi& E, unsigned long long* st) { if constexpr ((EPI_MASK & Epi::ID) != 0) gemm_phase<Epi, Sched, X>(lds, g, S, E, st); }
typedef unsigned u32x2 __attribute__((ext_vector_type(2)));

constexpr int DM = 1024, SEQ = 4096, NB = 16, NSB = 8, SL = 32;
constexpr int GB = 4, NG = NB / GB;
constexpr int MP = GB * SEQ;
constexpr int MSMP = NSB * SL;
constexpr int MLOC = MP + MSMP;
constexpr int NPROJ = 8704;
constexpr int NWIN = 8960;
constexpr int C_Q = 0, C_K = 512, C_V = 1024, C_GA = 1536, C_Z = 2048, C_XBC = 3072, C_GC = 4608, C_XC = 5120, C_GM = 5632;
constexpr float EPSN = 1e-6f;

constexpr size_t al256(size_t x) { return (x + 255) & ~(size_t)255; }
constexpr size_t WS_WIN = 0;
constexpr size_t WS_WCAT = WS_WIN + al256((size_t)2 * NWIN * 1024 * 2);
constexpr size_t WS_WOUT = WS_WCAT + al256((size_t)2 * 1024 * 2048 * 2);
constexpr size_t WS_WPG = WS_WOUT + al256((size_t)2 * 1024 * 1024 * 2);
constexpr size_t WS_WPP = WS_WPG + al256((size_t)2 * 1024 * 1024 * 2);
constexpr size_t WS_KC = WS_WPP + al256((size_t)2 * 1024 * 256 * 2);
constexpr size_t WS_VC = WS_KC + al256((size_t)2 * 8 * 512 * 512 * 2);
constexpr size_t WS_SS = WS_VC + al256((size_t)2 * 8 * 512 * 512 * 2);
constexpr size_t WS_CTR = WS_SS + al256((size_t)NG * 4 * MLOC * 4);
constexpr size_t WS_HBUF = WS_CTR + 1024;
constexpr size_t WS_PROJ = WS_HBUF + al256((size_t)MLOC * 1024 * 2);
constexpr size_t WS_DT = WS_PROJ + al256((size_t)MLOC * NPROJ * 2);
constexpr size_t WS_OCAT = WS_DT + al256((size_t)MLOC * 16 * 4);
constexpr int OC_A = 0, OC_B = 512, OC_C = 1536, OCW = 2048;
constexpr size_t WS_MIXB = WS_OCAT + al256((size_t)MLOC * 2048 * 2);
constexpr size_t WS_UBUF = WS_MIXB + al256((size_t)MLOC * 1024 * 2);
constexpr size_t WS_PBUF = WS_UBUF + al256((size_t)MLOC * 1024 * 2);
constexpr size_t WS_PP = WS_PBUF + al256((size_t)2 * MLOC * 256 * 2);
constexpr size_t WS_SSDS = WS_PP + al256((size_t)MLOC * 1024 * 2);
constexpr size_t WS_ACB = WS_SSDS + al256((size_t)GB * 64 * 16 * 4096 * 4);
constexpr size_t WS_HZ = WS_ACB + al256((size_t)GB * 64 * 16 * 4);
constexpr size_t WS_PZ = WS_HZ + al256((size_t)MP * 512 * 4);
constexpr size_t WS_LCA = WS_PZ + al256((size_t)MP * 512 * 4);
constexpr size_t WS_LCB = WS_LCA + al256((size_t)GB * 64 * 512 * 4);
constexpr size_t WS_BAR = WS_LCB + al256((size_t)GB * 64 * 512 * 4);
constexpr size_t WS_XRES = WS_BAR + 16384;
constexpr size_t WS_XACT = WS_XRES + al256((size_t)MLOC * 1024 * 2);
constexpr size_t WS_LWF = WS_XACT + al256((size_t)GB * 64 * 4 * 64 * 384 * 2);
constexpr size_t WS_END = WS_LWF + 262144;

constexpr size_t O_YP = 0;
constexpr size_t O_YS = O_YP + (size_t)NB * SEQ * DM;
constexpr size_t O_PK = O_YS + (size_t)NSB * SL * DM;
constexpr size_t O_PV = O_PK + (size_t)2 * NB * 512 * 512;
constexpr size_t O_PCB = O_PV + (size_t)2 * NB * 512 * 512;
constexpr size_t O_PSS = O_PCB + (size_t)2 * NB * 3 * 1536;
constexpr size_t O_PCC = O_PSS + (size_t)2 * NB * 16 * 64 * 64;
constexpr size_t O_PLR = O_PCC + (size_t)2 * NB * 3 * 512;
constexpr size_t O_SK = O_PLR + (size_t)2 * NB * 512;
constexpr size_t O_SV = O_SK + (size_t)2 * NSB * SL * 512;
constexpr size_t O_SCB = O_SV + (size_t)2 * NSB * SL * 512;
constexpr size_t O_SSS = O_SCB + (size_t)2 * NSB * 3 * 1536;
constexpr size_t O_SCC = O_SSS + (size_t)2 * NSB * 16 * 64 * 64;
constexpr size_t O_SLR = O_SCC + (size_t)2 * NSB * 3 * 512;
constexpr size_t O_END = O_SLR + (size_t)2 * NSB * 512;

struct Params { const float* in[35]; float* out; unsigned char* ws; };
enum { I_XP = 0, I_XS, I_CK, I_CV, I_SCB, I_SSM, I_SCC, I_SLR, I_PP, I_PS, I_NG, I_WIN, I_QN, I_KN, I_RB, I_CWB, I_CBB, I_DTB, I_ALOG, I_DSK, I_SNG, I_CWC, I_CBC,
       I_WRG, I_BRG, I_WIG, I_BIG, I_LAM, I_WOA, I_WOB, I_WOC, I_WOUT, I_PNG, I_WPG, I_WPP };

#define KCONST __attribute__((address_space(4)))
__device__ __forceinline__ Params load_params() { auto p = __builtin_amdgcn_kernarg_segment_ptr(); asm volatile("" : "+s"(p)); Params r; const KCONST unsigned long long* q = (const KCONST unsigned long long*)p;
#pragma unroll
    for (int i = 0; i < 35; ++i) r.in[i] = (const float*)(const __attribute__((address_space(1))) float*)q[i];
    r.out = (float*)(__attribute__((address_space(1))) float*)q[35]; r.ws = (unsigned char*)(__attribute__((address_space(1))) unsigned char*)q[36]; return r; }
__device__ __forceinline__ int otid(int wv) { int t; asm volatile("v_mbcnt_lo_u32_b32 %0, -1, 0\n\tv_mbcnt_hi_u32_b32 %0, -1, %0" : "=v"(t)); return t + wv * 64; }
__device__ __forceinline__ float bflo(unsigned w) { return __uint_as_float(w << 16); }
__device__ __forceinline__ float bfhi(unsigned w) { return __uint_as_float(w & 0xffff0000u); }
__device__ __forceinline__ float bf1(bf16_t b) { return __uint_as_float(((unsigned)b) << 16); }
__device__ __forceinline__ bf16_t f2bf(float f) { return (bf16_t)(cvt_pk_bf16(f, 0.f) & 0xffffu); }
__device__ __forceinline__ float bperm(float v, int srclane) { return __int_as_float(__builtin_amdgcn_ds_bpermute(srclane << 2, __float_as_int(v))); }
__device__ __forceinline__ float wsum4(float v, int lane) { v += bperm(v, lane ^ 16); v += bperm(v, lane ^ 32); return v; }
__device__ __forceinline__ float wmax4(float v, int lane) { v = fmaxf(v, bperm(v, lane ^ 16)); v = fmaxf(v, bperm(v, lane ^ 32)); return v; }
__device__ __forceinline__ float sigmoidf_(float x) { return __builtin_amdgcn_rcpf(1.0f + __builtin_amdgcn_exp2f(x * -1.44269504f)); }
__device__ __forceinline__ float siluf_(float x) { return x * __builtin_amdgcn_rcpf(1.0f + __builtin_amdgcn_exp2f(x * -1.44269504f)); }
__device__ __forceinline__ float softplusf_(float x) { const float e = __expf(x); return x > 15.f ? x : (x < -5.f ? e * (1.0f - 0.5f * e) : __logf(1.0f + e)); }
__device__ __forceinline__ void unpack8(const u32x4 r, float (&f)[8]) { f[0] = bflo(r.x); f[1] = bfhi(r.x); f[2] = bflo(r.y); f[3] = bfhi(r.y); f[4] = bflo(r.z); f[5] = bfhi(r.z); f[6] = bflo(r.w); f[7] = bfhi(r.w); }
__device__ __forceinline__ u32x4 pack8(const float (&f)[8]) { u32x4 r; r.x = cvt_pk_bf16(f[0], f[1]); r.y = cvt_pk_bf16(f[2], f[3]); r.z = cvt_pk_bf16(f[4], f[5]); r.w = cvt_pk_bf16(f[6], f[7]); return r; }
__device__ __forceinline__ bf16x8 as_bf8(u32x4 r) { union { u32x4 u; bf16x8 b; } c; c.u = r; return c.b; }
#define MFMA16(a, b, c) __builtin_amdgcn_mfma_f32_16x16x32_bf16((a), (b), (c), 0, 0, 0)
#define MEMFENCE() asm volatile("" ::: "memory")
#define LDSWAIT() asm volatile("s_waitcnt lgkmcnt(0)" ::: "memory")

__device__ __forceinline__ const float* x_row(const Params& P, int g, int lr) { return lr < MP ? P.in[I_XP] + ((size_t)g * MP + lr) * DM : P.in[I_XS] + (size_t)(lr - MP) * DM; }
__device__ __forceinline__ float* y_row(const Params& P, int g, int lr) { return lr < MP ? P.out + O_YP + ((size_t)g * MP + lr) * DM : P.out + O_YS + (size_t)(lr - MP) * DM; }


#define XB_TMO      128
#define XB_XCNT(j)  (256  + 64 * (j))
#define XB_XSUB(j)  (1280 + 64 * (j))
#define XB_XGEN(j)  (2304 + 64 * (j))
#define XB_TOP      3328
#define XB_TOPGEN   3392
#define XCD_BAR_WORDS 3456
#define XB_SPIN_CAP (1u << 18)
__device__ __forceinline__ unsigned xb_ld(unsigned* p)              { return __hip_atomic_load(p, __ATOMIC_RELAXED, __HIP_MEMORY_SCOPE_AGENT); }
__device__ __forceinline__ unsigned xb_add(unsigned* p, unsigned v) { return __hip_atomic_fetch_add(p, v, __ATOMIC_RELAXED, __HIP_MEMORY_SCOPE_AGENT); }
__device__ __forceinline__ unsigned xb_xcc_id() { return (unsigned)__builtin_amdgcn_s_getreg((3 << 11) | 20) & 0xFu; }
#define XB_SPIN(cond, bar) do { unsigned _sp = 0; while (cond) { __builtin_amdgcn_s_sleep(1); \
    if ((++_sp & 255u) == 0u) { if (xb_ld(&(bar)[XB_TMO])) break; if (_sp > XB_SPIN_CAP) { atomicAdd(&(bar)[XB_TMO], 1u); break; } } } } while (0)
__device__ __forceinline__ void xcd_barrier_complete(unsigned* bar, unsigned x, unsigned& nloc, unsigned& nx) {
    const unsigned G = gridDim.x;
    unsigned sum, cnt, mine, sp = 0u;
    for (;;) {
        sum = 0u; cnt = 0u; mine = 0u;
#pragma unroll
        for (unsigned j = 0; j < 16; ++j) { const unsigned c = xb_ld(&bar[XB_XCNT(j)]); sum += c; cnt += (c > 0u) ? 1u : 0u; mine = (j == x) ? c : mine; }
        if (sum == G) break;
        __builtin_amdgcn_s_sleep(1);
        if ((++sp & 255u) == 0u) { if (xb_ld(&bar[XB_TMO])) break; if (sp > XB_SPIN_CAP) { atomicAdd(&bar[XB_TMO], 1u); break; } }
    }
    nloc = mine > 0u ? mine : 1u; nx = cnt > 0u ? cnt : 1u;
}
__device__ __forceinline__ void xcd_sync(int wv, unsigned* bar, volatile unsigned* st) {
    asm volatile("s_waitcnt vmcnt(0)" ::: "memory");
    __syncthreads();
    if (otid(wv) == 0) {
        const unsigned x = xb_xcc_id();
        __builtin_amdgcn_s_waitcnt(0);
        unsigned nloc = st[0], nx = st[1];
        if (nloc == 0u) { xcd_barrier_complete(bar, x, nloc, nx); st[0] = nloc; st[1] = nx; }
        const unsigned old = xb_add(&bar[XB_XSUB(x)], 1u);
        const unsigned gen = old / nloc;
        if (old + 1u == (gen + 1u) * nloc) {
            __builtin_amdgcn_fence(__ATOMIC_RELEASE, "agent");
            asm volatile("s_waitcnt vmcnt(0)" ::: "memory");
            const unsigned og = xb_add(&bar[XB_TOP], 1u);
            const unsigned tg = og / nx;
            if (og + 1u == (tg + 1u) * nx) xb_add(&bar[XB_TOPGEN], 1u);
            else XB_SPIN(xb_ld(&bar[XB_TOPGEN]) == tg, bar);
            __builtin_amdgcn_fence(__ATOMIC_ACQUIRE, "agent");
            xb_add(&bar[XB_XGEN(x)], 1u);
            asm volatile("s_waitcnt vmcnt(0)" ::: "memory");
        } else {
            XB_SPIN(xb_ld(&bar[XB_XGEN(x)]) == gen, bar);
            __builtin_amdgcn_fence(__ATOMIC_ACQUIRE, "agent");
            asm volatile("s_waitcnt vmcnt(0)" ::: "memory");
        }
    }
    __syncthreads();
}

struct EpiIn { static constexpr int ID = 1; static constexpr bool HAS_MID = false; static constexpr int T1 = -1, T2 = -1;
    static constexpr bool PERM = true, AFTER_DRAIN = false;
    bf16_t* proj; float* dtb; const float* ss;
    __device__ __forceinline__ void operator()(const f32x4 (&acc)[2][2][4][2], const Unit& u, int wr, int wc, int fr, int fq) const {
        const int row0 = u.pm * BM + wr * 64 + fr;
        float rs[2][4];
#pragma unroll
        for (int ai = 0; ai < 2; ++ai)
#pragma unroll
            for (int m = 0; m < 4; ++m) rs[ai][m] = ss[row0 + ai * HALF + m * 16];
#pragma unroll
        for (int ai = 0; ai < 2; ++ai)
#pragma unroll
            for (int m = 0; m < 4; ++m) {
                const int row = row0 + ai * HALF + m * 16;
                const float r = __builtin_amdgcn_rsqf(rs[ai][m] * (1.0f / 1024.0f) + EPSN);
                if (u.pn < 34) {
                    bf16_t* rp = proj + (size_t)row * NPROJ + u.pn * BM + wc * 32 + 8 * fq;
#pragma unroll
                    for (int bj = 0; bj < 2; ++bj) { const f32x4 v0 = acc[ai][bj][m][0] * r, v1 = acc[ai][bj][m][1] * r;
                        u32x4 w; w.x = cvt_pk_bf16(v0[0], v0[1]); w.y = cvt_pk_bf16(v0[2], v0[3]); w.z = cvt_pk_bf16(v1[0], v1[1]); w.w = cvt_pk_bf16(v1[2], v1[3]);
                        *(u32x4*)(rp + bj * HALF) = w; }
                } else if (wc == 0 && fq < 2) {
                    float* dp = dtb + (size_t)row * 16 + 8 * fq;
                    *(f32x4*)dp = acc[ai][0][m][0] * r; *(f32x4*)(dp + 4) = acc[ai][0][m][1] * r;
                }
            }
    }
};
struct EpiMergeF { static constexpr int ID = 2;
    static constexpr bool PERM = true, AFTER_DRAIN = false, HAS_MID = true;
    static constexpr int T1 = 8, T2 = 24;
    const bf16_t* gate; bf16_t* mixb;
    struct Ld2 { u32x4 a[2], b[2]; };
    __device__ __forceinline__ void ld2(Ld2& d, unsigned row, unsigned col0, unsigned offa) const {
        const unsigned go = row * NPROJ + col0 + offa;
#pragma unroll
        for (int bj = 0; bj < 2; ++bj) { d.a[bj] = *(const u32x4*)(gate + go + bj * HALF); d.b[bj] = *(const u32x4*)(gate + go + 1024 + bj * HALF); }
    }
    static __device__ __forceinline__ float ratio(float ga, float gb) { return (1.0f + __builtin_amdgcn_exp2f(gb * -1.44269504f)) * __builtin_amdgcn_rcpf(1.0f + __builtin_amdgcn_exp2f(ga * -1.44269504f)); }
    __device__ __forceinline__ void mid(f32x4 (&acc)[2][2][4][2], const Unit& u, int t, int wr, int wc, int fr, int fq) const {
        const unsigned row0 = u.pm * BM + wr * 64 + fr, col0 = u.pn * BM + wc * 32 + 8 * fq, offa = (t == T1) ? 0u : 1024u;
        Ld2 cur, nxt; ld2(cur, row0, col0, offa);
#pragma unroll
        for (int rr = 0; rr < 8; ++rr) {
            const int ai = rr >> 2, m = rr & 3;
            if (rr < 7) ld2(nxt, row0 + ((rr + 1) >> 2) * HALF + ((rr + 1) & 3) * 16, col0, offa);
            MEMFENCE();
#pragma unroll
            for (int bj = 0; bj < 2; ++bj) { float ga[8], gb[8]; unpack8(cur.a[bj], ga); unpack8(cur.b[bj], gb);
#pragma unroll
                for (int e = 0; e < 4; ++e) { acc[ai][bj][m][0][e] *= ratio(ga[e], gb[e]); acc[ai][bj][m][1][e] *= ratio(ga[4 + e], gb[4 + e]); } }
            MEMFENCE();
            cur = nxt;
        }
    }
    struct Ld1 { u32x4 a[2]; };
    __device__ __forceinline__ void ld1(Ld1& d, unsigned row, unsigned col0) const {
        const unsigned go = row * NPROJ + col0 + 2048u;
#pragma unroll
        for (int bj = 0; bj < 2; ++bj) d.a[bj] = *(const u32x4*)(gate + go + bj * HALF);
    }
    __device__ __forceinline__ void operator()(const f32x4 (&acc)[2][2][4][2], const Unit& u, int wr, int wc, int fr, int fq) const {
        const unsigned row0 = u.pm * BM + wr * 64 + fr, col0 = u.pn * BM + wc * 32 + 8 * fq;
        Ld1 cur, nxt, nx2; ld1(cur, row0, col0); ld1(nxt, row0 + 16, col0);
#pragma unroll
        for (int rr = 0; rr < 8; ++rr) {
            const int ai = rr >> 2, m = rr & 3;
            const unsigned row = row0 + ai * HALF + m * 16, mo = row * DM + col0;
            if (rr < 6) ld1(nx2, row0 + ((rr + 2) >> 2) * HALF + ((rr + 2) & 3) * 16, col0);
            MEMFENCE();
#pragma unroll
            for (int bj = 0; bj < 2; ++bj) { float gw[8]; unpack8(cur.a[bj], gw); const f32x4 v0 = acc[ai][bj][m][0], v1 = acc[ai][bj][m][1];
                u32x4 w; w.x = cvt_pk_bf16(v0[0] * sigmoidf_(gw[0]), v0[1] * sigmoidf_(gw[1])); w.y = cvt_pk_bf16(v0[2] * sigmoidf_(gw[2]), v0[3] * sigmoidf_(gw[3]));
                w.z = cvt_pk_bf16(v1[0] * sigmoidf_(gw[4]), v1[1] * sigmoidf_(gw[5])); w.w = cvt_pk_bf16(v1[2] * sigmoidf_(gw[6]), v1[3] * sigmoidf_(gw[7]));
                *(u32x4*)(mixb + mo + bj * HALF) = w; }
            MEMFENCE();
            cur = nxt; nxt = nx2;
        }
    }
};
struct EpiOut { static constexpr int ID = 4; static constexpr bool HAS_MID = false; static constexpr int T1 = -1, T2 = -1;
    static constexpr bool PERM = true, AFTER_DRAIN = false;
    const float* xa; const float* xb; bf16_t* xres; bf16_t* ub; const float* pg; float* ss; int first;
    struct Ld { f32x4 x[2][2]; };
    __device__ __forceinline__ void ld(Ld& d, const float* xbase, unsigned row, unsigned col0) const {
        const unsigned ro = row * DM + col0;
#pragma unroll
        for (int bj = 0; bj < 2; ++bj) { const unsigned cc = bj * HALF;
            if (first) { d.x[bj][0] = *(const f32x4*)(xbase + ro + cc); d.x[bj][1] = *(const f32x4*)(xbase + ro + cc + 4); }
            else { const u32x4 w = *(const u32x4*)(xres + ro + cc); d.x[bj][0] = (f32x4){bflo(w.x), bfhi(w.x), bflo(w.y), bfhi(w.y)}; d.x[bj][1] = (f32x4){bflo(w.z), bfhi(w.z), bflo(w.w), bfhi(w.w)}; } }
    }
    __device__ __forceinline__ void operator()(const f32x4 (&acc)[2][2][4][2], const Unit& u, int wr, int wc, int fr, int fq) const {
        const int lane = fr + 16 * fq;
        const unsigned row0 = u.pm * BM + wr * 64 + fr, col0 = u.pn * BM + wc * 32 + 8 * fq;
        const bool smp = (u.pm * BM) >= MP;
        const float* xbase = smp ? xb - (size_t)MP * DM : xa;
        f32x4 gv[2][2];
#pragma unroll
        for (int bj = 0; bj < 2; ++bj) { gv[bj][0] = *(const f32x4*)(pg + col0 + bj * HALF); gv[bj][1] = *(const f32x4*)(pg + col0 + bj * HALF + 4); }
        Ld cur, nxt; ld(cur, xbase, row0, col0);
#pragma unroll
        for (int rr = 0; rr < 8; ++rr) {
            const int ai = rr >> 2, m = rr & 3;
            const unsigned row = row0 + ai * HALF + m * 16, ro = row * DM + col0;
            if (rr < 7) ld(nxt, xbase, row0 + ((rr + 1) >> 2) * HALF + ((rr + 1) & 3) * 16, col0);
            MEMFENCE();
            float s = 0.f;
#pragma unroll
            for (int bj = 0; bj < 2; ++bj) {
                const unsigned cc = bj * HALF;
                const f32x4 v0 = cur.x[bj][0] + acc[ai][bj][m][0], v1 = cur.x[bj][1] + acc[ai][bj][m][1];
                u32x4 xw; xw.x = cvt_pk_bf16(v0[0], v0[1]); xw.y = cvt_pk_bf16(v0[2], v0[3]); xw.z = cvt_pk_bf16(v1[0], v1[1]); xw.w = cvt_pk_bf16(v1[2], v1[3]); *(u32x4*)(xres + ro + cc) = xw;
                s += ((v0[0] * v0[0] + v0[1] * v0[1]) + (v0[2] * v0[2] + v0[3] * v0[3])) + ((v1[0] * v1[0] + v1[1] * v1[1]) + (v1[2] * v1[2] + v1[3] * v1[3]));
                const f32x4 q0 = v0 * gv[bj][0], q1 = v1 * gv[bj][1];
                u32x4 w; w.x = cvt_pk_bf16(q0[0], q0[1]); w.y = cvt_pk_bf16(q0[2], q0[3]); w.z = cvt_pk_bf16(q1[0], q1[1]); w.w = cvt_pk_bf16(q1[2], q1[3]); *(u32x4*)(ub + ro + cc) = w;
            }
            s = wsum4(s, lane);
            if (fq == 0) atomicAdd(ss + row, s);
            MEMFENCE();
            cur = nxt;
        }
    }
};
struct EpiPP { static constexpr int ID = 8; static constexpr bool HAS_MID = false; static constexpr int T1 = -1, T2 = -1;
    static constexpr bool PERM = true, AFTER_DRAIN = false;
    bf16_t* pp;
    __device__ __forceinline__ void operator()(const f32x4 (&acc)[2][2][4][2], const Unit& u, int wr, int wc, int fr, int fq) const {
        const int row0 = u.pm * BM + wr * 64 + fr;
#pragma unroll
        for (int ai = 0; ai < 2; ++ai)
#pragma unroll
            for (int m = 0; m < 4; ++m) {
                bf16_t* rp = pp + (size_t)(row0 + ai * HALF + m * 16) * DM + u.pn * BM + wc * 32 + 8 * fq;
#pragma unroll
                for (int bj = 0; bj < 2; ++bj) { const f32x4 v0 = acc[ai][bj][m][0], v1 = acc[ai][bj][m][1];
                    u32x4 w; w.x = cvt_pk_bf16(v0[0], v0[1]); w.y = cvt_pk_bf16(v0[2], v0[3]); w.z = cvt_pk_bf16(v1[0], v1[1]); w.w = cvt_pk_bf16(v1[2], v1[3]);
                    *(u32x4*)(rp + bj * HALF) = w; }
                MEMFENCE();
            }
    }
};
struct EpiGate { static constexpr int ID = 16; static constexpr bool HAS_MID = false; static constexpr int T1 = -1, T2 = -1;
    static constexpr bool PERM = true, AFTER_DRAIN = false;
    float* ya; float* yb; const bf16_t* pp; const float* ssp; bf16_t* hb; const float* ng; float* ssn; bf16_t* xres;
    struct Ld { u32x4 p[2]; u32x4 x[2]; float s; };
    __device__ __forceinline__ void ld(Ld& d, unsigned row, unsigned col0) const {
        const unsigned ro = row * DM + col0; d.s = ssp[row];
#pragma unroll
        for (int bj = 0; bj < 2; ++bj) { d.p[bj] = *(const u32x4*)(pp + ro + bj * HALF); d.x[bj] = *(const u32x4*)(xres + ro + bj * HALF); }
    }
    __device__ __forceinline__ void operator()(const f32x4 (&acc)[2][2][4][2], const Unit& u, int wr, int wc, int fr, int fq) const {
        const int lane = fr + 16 * fq;
        const unsigned row0 = u.pm * BM + wr * 64 + fr, col0 = u.pn * BM + wc * 32 + 8 * fq;
        const bool smp = (u.pm * BM) >= MP;
        float* ybase = smp ? yb - (size_t)MP * DM : ya;
        f32x4 gv[2][2];
#pragma unroll
        for (int bj = 0; bj < 2; ++bj) { gv[bj][0] = hb ? *(const f32x4*)(ng + col0 + bj * HALF) : (f32x4){0.f, 0.f, 0.f, 0.f}; gv[bj][1] = hb ? *(const f32x4*)(ng + col0 + bj * HALF + 4) : (f32x4){0.f, 0.f, 0.f, 0.f}; }
        Ld cur, nxt; ld(cur, row0, col0);
#pragma unroll
        for (int rr = 0; rr < 8; ++rr) {
            const int ai = rr >> 2, m = rr & 3;
            const unsigned row = row0 + ai * HALF + m * 16, ro = row * DM + col0;
            if (rr < 7) ld(nxt, row0 + ((rr + 1) >> 2) * HALF + ((rr + 1) & 3) * 16, col0);
            MEMFENCE();
            const float r = __builtin_amdgcn_rsqf(cur.s * (1.0f / 1024.0f) + EPSN);
            float s = 0.f;
#pragma unroll
            for (int bj = 0; bj < 2; ++bj) {
                const unsigned cc = bj * HALF; float pf8[8], xf8[8]; unpack8(cur.p[bj], pf8); unpack8(cur.x[bj], xf8);
                const float r2 = r * -1.44269504f;
                const f32x4 a0 = acc[ai][bj][m][0] * r2, a1 = acc[ai][bj][m][1] * r2;
                f32x4 v0, v1;
#pragma unroll
                for (int e = 0; e < 4; ++e) { v0[e] = xf8[e] + __builtin_amdgcn_rcpf(1.0f + __builtin_amdgcn_exp2f(a0[e])) * pf8[e]; v1[e] = xf8[4 + e] + __builtin_amdgcn_rcpf(1.0f + __builtin_amdgcn_exp2f(a1[e])) * pf8[4 + e]; }
                if (hb) { s += ((v0[0] * v0[0] + v0[1] * v0[1]) + (v0[2] * v0[2] + v0[3] * v0[3])) + ((v1[0] * v1[0] + v1[1] * v1[1]) + (v1[2] * v1[2] + v1[3] * v1[3]));
                    const f32x4 q0 = v0 * gv[bj][0], q1 = v1 * gv[bj][1];
                    u32x4 w; w.x = cvt_pk_bf16(q0[0], q0[1]); w.y = cvt_pk_bf16(q0[2], q0[3]); w.z = cvt_pk_bf16(q1[0], q1[1]); w.w = cvt_pk_bf16(q1[2], q1[3]); *(u32x4*)(hb + ro + cc) = w;
                    u32x4 xo; xo.x = cvt_pk_bf16(v0[0], v0[1]); xo.y = cvt_pk_bf16(v0[2], v0[3]); xo.z = cvt_pk_bf16(v1[0], v1[1]); xo.w = cvt_pk_bf16(v1[2], v1[3]); *(u32x4*)(xres + ro + cc) = xo; }
                else { *(f32x4*)(ybase + ro + cc) = v0; *(f32x4*)(ybase + ro + cc + 4) = v1; }
            }
            if (hb) { s = wsum4(s, lane); if (fq == 0) atomicAdd(ssn + row, s); }
            MEMFENCE();
            cur = nxt;
        }
    }
};

__device__ __forceinline__ void transpose_job(int wv, const float* src, bf16_t* dst, int K, int Nsrc, int Ndst, bool win_map, float* tile  , int ldd = 0) {
    if (ldd == 0) ldd = K;
    const int tid = otid(wv); const int ntk = K / 64, ntn = Ndst / 64, nt = ntk * ntn;
    for (int t = blockIdx.x; t < nt; t += gridDim.x) {
        const int kt = t % ntk, ntile = t / ntk, k0 = kt * 64, n0 = ntile * 64;
        int srcc = n0, valid = 64;
        if (win_map) { if (n0 < 4608) srcc = n0; else if (n0 < 8704) srcc = n0 + 16; else if (n0 == 8704) { srcc = 4608; valid = 16; } else { srcc = 0; valid = 0; } }
        __syncthreads();
        { const int j = tid & 63, i0 = tid >> 6;
#pragma unroll
          for (int ii = 0; ii < 8; ++ii) { const int i = i0 + 8 * ii; tile[i * 65 + j] = (j < valid) ? src[(size_t)(k0 + i) * Nsrc + srcc + j] : 0.f; } }
        __syncthreads();
        { const int i2 = tid & 31, j0 = tid >> 5;
#pragma unroll
          for (int jj = 0; jj < 4; ++jj) { const int j = j0 + 16 * jj; *(unsigned*)(dst + (size_t)(n0 + j) * ldd + k0 + 2 * i2) = cvt_pk_bf16(tile[(2 * i2) * 65 + j], tile[(2 * i2 + 1) * 65 + j]); } }
    }
}
__device__ __forceinline__ void phase_weights(int wv, const Params& P, unsigned char* lds) {
    float* tile = (float*)lds;
    for (int l = 0; l < 2; ++l) {
        transpose_job(wv, P.in[I_WIN] + (size_t)l * 1024 * 8720, (bf16_t*)(P.ws + WS_WIN) + (size_t)l * NWIN * 1024, 1024, 8720, NWIN, true, tile);
        transpose_job(wv, P.in[I_WOA] + (size_t)l * 512 * 1024, (bf16_t*)(P.ws + WS_WCAT) + (size_t)l * 1024 * 2048 + OC_A, 512, 1024, 1024, false, tile, 2048);
        transpose_job(wv, P.in[I_WOB] + (size_t)l * 1024 * 1024, (bf16_t*)(P.ws + WS_WCAT) + (size_t)l * 1024 * 2048 + OC_B, 1024, 1024, 1024, false, tile, 2048);
        transpose_job(wv, P.in[I_WOC] + (size_t)l * 512 * 1024, (bf16_t*)(P.ws + WS_WCAT) + (size_t)l * 1024 * 2048 + OC_C, 512, 1024, 1024, false, tile, 2048);
        transpose_job(wv, P.in[I_WOUT] + (size_t)l * 1024 * 1024, (bf16_t*)(P.ws + WS_WOUT) + (size_t)l * 1024 * 1024, 1024, 1024, 1024, false, tile);
        transpose_job(wv, P.in[I_WPG] + (size_t)l * 1024 * 1024, (bf16_t*)(P.ws + WS_WPG) + (size_t)l * 1024 * 1024, 1024, 1024, 1024, false, tile);
        transpose_job(wv, P.in[I_WPP] + (size_t)l * 256 * 1024, (bf16_t*)(P.ws + WS_WPP) + (size_t)l * 1024 * 256, 256, 1024, 1024, false, tile);
    }
    const size_t gt = (size_t)blockIdx.x * 512 + otid(wv), gs = (size_t)gridDim.x * 512;
    { const size_t n4 = (size_t)2 * 8 * 512 * 512 / 4; const f32x4* ck = (const f32x4*)P.in[I_CK]; const f32x4* cv = (const f32x4*)P.in[I_CV]; u32x2* dk = (u32x2*)(P.ws + WS_KC); u32x2* dv = (u32x2*)(P.ws + WS_VC);
      for (size_t i = gt; i < n4; i += gs) { const f32x4 a = ck[i], b = cv[i]; u32x2 w; w.x = cvt_pk_bf16(a[0], a[1]); w.y = cvt_pk_bf16(a[2], a[3]); dk[i] = w; w.x = cvt_pk_bf16(b[0], b[1]); w.y = cvt_pk_bf16(b[2], b[3]); dv[i] = w; } }
    if (gt < 16384) { const int e = (int)gt, ln = e & 63, gate = (e >> 6) & 1, ks = (e >> 7) & 1, ct = (e >> 8) & 3, kb = (e >> 10) & 7, ll = e >> 13, fr_ = ln & 15, fq_ = ln >> 4;
        const float* wsrc = (gate ? P.in[I_WIG] : P.in[I_WRG]) + ((size_t)(ll * 8 + kb) * 64 + 32 * ks + 8 * fq_) * 64 + 16 * ct + fr_;
        float a[8];
#pragma unroll
        for (int q = 0; q < 8; ++q) a[q] = wsrc[q * 64];
        ((u32x4*)(P.ws + WS_LWF))[e] = pack8(a); }
    { float* ss = (float*)(P.ws + WS_SS); const size_t n = (size_t)NG * 4 * MLOC; for (size_t i = gt; i < n; i += gs) if ((((unsigned)i / (unsigned)MLOC) & 3u) != 0u) ss[i] = 0.f;
      if (gt < 256) ((unsigned*)(P.ws + WS_CTR))[gt] = 0u;
      if (gt < XCD_BAR_WORDS) ((unsigned*)(P.ws + WS_BAR))[gt] = 0u; }
}

__device__ __forceinline__ void phase_prep(int wv, const Params& P, int g) {
    const int M = (g == 0) ? MLOC : MP; const int tid = otid(wv); const int w = tid >> 6, lane = tid & 63;
    bf16_t* hb = (bf16_t*)(P.ws + WS_HBUF); float* ss = (float*)(P.ws + WS_SS) + (size_t)(g * 4 + 0) * MLOC; bf16_t* pb = (bf16_t*)(P.ws + WS_PBUF);
    const float* ng = P.in[I_NG];
    f32x4 gv[4];
#pragma unroll
    for (int k = 0; k < 4; ++k) gv[k] = *(const f32x4*)(ng + k * 256 + lane * 4);
    for (int row = blockIdx.x * 8 + w; row < M; row += gridDim.x * 8) {
        const float* xr = x_row(P, g, row); float s = 0.f;
#pragma unroll
        for (int k = 0; k < 4; ++k) { const f32x4 v = *(const f32x4*)(xr + k * 256 + lane * 4); s += (v[0] * v[0] + v[1] * v[1]) + (v[2] * v[2] + v[3] * v[3]);
            const f32x4 q = v * gv[k]; u32x2 o; o.x = cvt_pk_bf16(q[0], q[1]); o.y = cvt_pk_bf16(q[2], q[3]); *(u32x2*)(hb + (size_t)row * DM + k * 256 + lane * 4) = o; }
#pragma unroll
        for (int o = 32; o >= 1; o >>= 1) s += bperm(s, lane ^ o);
        if (lane == 0) ss[row] = s;
#pragma unroll
        for (int l = 0; l < 2; ++l) {
            const float* pr = row < MP ? P.in[I_PP] + (((size_t)l * NB * SEQ) + (size_t)g * MP + row) * 256 : P.in[I_PS] + (((size_t)l * MSMP) + (row - MP)) * 256;
            const f32x4 v = *(const f32x4*)(pr + lane * 4); u32x2 o; o.x = cvt_pk_bf16(v[0], v[1]); o.y = cvt_pk_bf16(v[2], v[3]);
            *(u32x2*)(pb + ((size_t)l * MLOC + row) * 256 + lane * 4) = o;
        }
    }
}

__device__ __forceinline__ void attn_item(int wv, const Params& P, int g, int l, int item, bool sample, unsigned char* lds) {
    const int tid = otid(wv), w = tid >> 6, lane = tid & 63, fr = lane & 15, fq = lane >> 4, h = w;
    bf16_t* vt = (bf16_t*)(lds + w * 19712);
    bf16_t* qs = (bf16_t*)(lds + w * 19712 + 9216);
    float* btab = (float*)(lds + w * 19712 + 18432);
    const float* rb = P.in[I_RB] + (size_t)(l * 8 + h) * 257;
    for (int i = lane; i < 257; i += 64) btab[i] = rb[i] * 1.44269504f;
    const float bconst = rb[256] * 1.44269504f;
    const bf16_t* proj = (const bf16_t*)(P.ws + WS_PROJ);
    int qrow0, nq, ntile, bl = 0, c = 0, sb = 0;
    if (!sample) { bl = item >> 6; c = item & 63; qrow0 = bl * SEQ + c * 64; nq = 64; ntile = (c < 8 ? c : 8) + 1; }
    else { sb = item; qrow0 = MP + sb * SL; nq = SL; ntile = 9; }
    float gq[2][8];
#pragma unroll
    for (int ks = 0; ks < 2; ++ks)
#pragma unroll
        for (int e = 0; e < 8; ++e) gq[ks][e] = P.in[I_QN][l * 64 + 32 * ks + 8 * fq + e] * (0.125f * 1.44269504f);
    const float* gkp = P.in[I_KN] + l * 64 + 8 * fq;
#pragma unroll
    for (int qt = 0; qt < 4; ++qt) {
        int qi = 16 * qt + fr; if (qi > nq - 1) qi = nq - 1;
        const bf16_t* qp = proj + (size_t)(qrow0 + qi) * NPROJ + C_Q + h * 64 + 8 * fq;
        float f0[8], f1[8]; unpack8(*(const u32x4*)qp, f0); unpack8(*(const u32x4*)(qp + 32), f1);
        float s = 0.f;
#pragma unroll
        for (int e = 0; e < 8; ++e) s += f0[e] * f0[e] + f1[e] * f1[e];
        s = wsum4(s, lane); const float r = __builtin_amdgcn_rsqf(s * (1.0f / 64.0f) + EPSN);
#pragma unroll
        for (int e = 0; e < 8; ++e) { f0[e] *= r * gq[0][e]; f1[e] *= r * gq[1][e]; }
        *(u32x4*)(qs + (16 * qt + fr) * 72 + 8 * fq) = pack8(f0); *(u32x4*)(qs + (16 * qt + fr) * 72 + 32 + 8 * fq) = pack8(f1);
    }
    float mrun[4], lrun[4]; f32x4 o[4][4];
#pragma unroll
    for (int qt = 0; qt < 4; ++qt) { mrun[qt] = -1e30f; lrun[qt] = 0.f;
#pragma unroll
        for (int dt = 0; dt < 4; ++dt) o[dt][qt] = (f32x4){0.f, 0.f, 0.f, 0.f}; }
    LDSWAIT();
    auto desc = [&](int ti, const bf16_t*& kp, const bf16_t*& vp, int& stride, int& donorm, int& relbase, int& nvalid, float*& ko, float*& vo) {
        ko = nullptr; vo = nullptr;
        if (!sample) { const int j = ntile - 1 - ti, kc = c - j; const size_t r0 = (size_t)(bl * SEQ + kc * 64);
            kp = proj + r0 * NPROJ + C_K + h * 64; vp = proj + r0 * NPROJ + C_V + h * 64; stride = NPROJ; donorm = 1; relbase = 64 * j; nvalid = 64;
            if (j == 0 && c >= 56) { const size_t orow = ((size_t)(l * NB + g * GB + bl) * 512 + (c - 56) * 64) * 512 + h * 64; ko = P.out + O_PK + orow; vo = P.out + O_PV + orow; } }
        else if (ti < 8) { const size_t r0 = ((size_t)(l * NSB + sb) * 512 + ti * 64) * 512 + h * 64;
            kp = (const bf16_t*)(P.ws + WS_KC) + r0; vp = (const bf16_t*)(P.ws + WS_VC) + r0; stride = 512; donorm = 0; relbase = 512 - 64 * ti; nvalid = 64; }
        else { const size_t r0 = (size_t)(MP + sb * SL);
            kp = proj + r0 * NPROJ + C_K + h * 64; vp = proj + r0 * NPROJ + C_V + h * 64; stride = NPROJ; donorm = 1; relbase = 0; nvalid = SL;
            const size_t orow = ((size_t)(l * NSB + sb) * SL) * 512 + h * 64; ko = P.out + O_SK + orow; vo = P.out + O_SV + orow; }
    };
    u32x4 kraw[4][2];
    auto loadk = [&](int ti) {
        const bf16_t* kp; const bf16_t* vp; int stride, donorm, relbase, nvalid; float* ko; float* vo; desc(ti, kp, vp, stride, donorm, relbase, nvalid, ko, vo);
        asm volatile("" : "+s"(stride));
#pragma unroll
        for (int kt = 0; kt < 4; ++kt) { const int kk = 32 * (kt >> 1) + 8 * (fr >> 2) + 4 * (kt & 1) + (fr & 3); const int kl = kk < nvalid ? kk : nvalid - 1;
            const unsigned ko32 = ((unsigned)kl * (unsigned)stride + 8u * fq) * 2u; kraw[kt][0] = *(const u32x4*)((const char*)kp + ko32); kraw[kt][1] = *(const u32x4*)((const char*)kp + ko32 + 64u); }
    };
    for (int ti = 0; ti < ntile; ++ti) {
        const bf16_t* kp; const bf16_t* vp; int stride, donorm, relbase, nvalid; float* ko; float* vo; desc(ti, kp, vp, stride, donorm, relbase, nvalid, ko, vo);
        MEMFENCE();
        u32x4 va[4], vb[4];
        { int st_ = stride; asm volatile("" : "+s"(st_)); stride = st_; }
        { const int i = lane & 31;
#pragma unroll
          for (int pp = 0; pp < 4; ++pp) { const int dg = (lane >> 5) + 2 * pp; int k0 = 2 * i, k1 = 2 * i + 1; if (k0 >= nvalid) k0 = nvalid - 1; if (k1 >= nvalid) k1 = nvalid - 1;
              va[pp] = *(const u32x4*)((const char*)vp + ((unsigned)k0 * (unsigned)stride + 8u * dg) * 2u); vb[pp] = *(const u32x4*)((const char*)vp + ((unsigned)k1 * (unsigned)stride + 8u * dg) * 2u); } }
        loadk(ti);
        bf16x8 kf[4][2];
        float gk[2][8];
        if (donorm) {
#pragma unroll
            for (int ks = 0; ks < 2; ++ks) { const f32x4 a = *(const f32x4*)(gkp + 32 * ks), b = *(const f32x4*)(gkp + 32 * ks + 4);
#pragma unroll
                for (int e = 0; e < 4; ++e) { gk[ks][e] = a[e]; gk[ks][4 + e] = b[e]; } }
        } else {
#pragma unroll
            for (int ks = 0; ks < 2; ++ks)
#pragma unroll
                for (int e = 0; e < 8; ++e) gk[ks][e] = 1.f;
        }
#pragma unroll
        for (int kt = 0; kt < 4; ++kt) {
            const int kk = 32 * (kt >> 1) + 8 * (fr >> 2) + 4 * (kt & 1) + (fr & 3); const bool okk = kk < nvalid;
            const u32x4 r0 = kraw[kt][0], r1 = kraw[kt][1];
            if (donorm) {
                float f0[8], f1[8]; unpack8(r0, f0); unpack8(r1, f1);
                float s = 0.f;
#pragma unroll
                for (int e = 0; e < 8; ++e) s += f0[e] * f0[e] + f1[e] * f1[e];
                s = wsum4(s, lane); const float r = __builtin_amdgcn_rsqf(s * (1.0f / 64.0f) + EPSN);
#pragma unroll
                for (int e = 0; e < 8; ++e) { f0[e] *= r * gk[0][e]; f1[e] *= r * gk[1][e]; }
                if (ko && okk) { float* d = ko + (size_t)kk * 512 + 8 * fq; *(f32x4*)d = (f32x4){f0[0], f0[1], f0[2], f0[3]}; *(f32x4*)(d + 4) = (f32x4){f0[4], f0[5], f0[6], f0[7]};
                    *(f32x4*)(d + 32) = (f32x4){f1[0], f1[1], f1[2], f1[3]}; *(f32x4*)(d + 36) = (f32x4){f1[4], f1[5], f1[6], f1[7]}; }
                kf[kt][0] = as_bf8(pack8(f0)); kf[kt][1] = as_bf8(pack8(f1));
            } else { kf[kt][0] = as_bf8(r0); kf[kt][1] = as_bf8(r1); }
        }
        { const int i = lane & 31;
#pragma unroll
          for (int pp = 0; pp < 4; ++pp) {
              const int dg = (lane >> 5) + 2 * pp; const int k0 = 2 * i, k1 = 2 * i + 1; const bool ok0 = k0 < nvalid, ok1 = k1 < nvalid;
              const u32x4 a = va[pp], b = vb[pp];
              unsigned* dst = (unsigned*)(vt + (8 * dg) * 72 + 2 * i);
              dst[0 * 36] = (a.x & 0xffffu) | (b.x << 16); dst[1 * 36] = (a.x >> 16) | (b.x & 0xffff0000u);
              dst[2 * 36] = (a.y & 0xffffu) | (b.y << 16); dst[3 * 36] = (a.y >> 16) | (b.y & 0xffff0000u);
              dst[4 * 36] = (a.z & 0xffffu) | (b.z << 16); dst[5 * 36] = (a.z >> 16) | (b.z & 0xffff0000u);
              dst[6 * 36] = (a.w & 0xffffu) | (b.w << 16); dst[7 * 36] = (a.w >> 16) | (b.w & 0xffff0000u);
              if (vo) { float f[8];
                  if (ok0) { unpack8(a, f); float* d = vo + (size_t)k0 * 512 + 8 * dg; *(f32x4*)d = (f32x4){f[0], f[1], f[2], f[3]}; *(f32x4*)(d + 4) = (f32x4){f[4], f[5], f[6], f[7]}; }
                  if (ok1) { unpack8(b, f); float* d = vo + (size_t)k1 * 512 + 8 * dg; *(f32x4*)d = (f32x4){f[0], f[1], f[2], f[3]}; *(f32x4*)(d + 4) = (f32x4){f[4], f[5], f[6], f[7]}; } }
          } }
        const bool cbias = relbase >= 191;
        LDSWAIT();
#pragma unroll
        for (int qt = 0; qt < 4; ++qt) {
            f32x4 s[4];
            { const bf16x8 q0 = *(const bf16x8*)(qs + (16 * qt + fr) * 72 + 8 * fq), q1 = *(const bf16x8*)(qs + (16 * qt + fr) * 72 + 32 + 8 * fq);
#pragma unroll
              for (int kt = 0; kt < 4; ++kt) { s[kt] = MFMA16(kf[kt][0], q0, ((f32x4){0.f, 0.f, 0.f, 0.f})); s[kt] = MFMA16(kf[kt][1], q1, s[kt]); } }
            const int qi = 16 * qt + fr; float mx = -1e30f;
#pragma unroll
            for (int kt = 0; kt < 4; ++kt)
#pragma unroll
                for (int jj = 0; jj < 4; ++jj) {
                    const int kk = 32 * (kt >> 1) + 8 * fq + 4 * (kt & 1) + jj;
                    float bias;
                    if (cbias) bias = bconst; else { int rel = relbase + qi - kk; rel = rel < -128 ? -128 : (rel > 128 ? 128 : rel); bias = btab[rel + 128]; }
                    float v = s[kt][jj] + bias; if (kk >= nvalid) v = -1e30f;
                    s[kt][jj] = v; mx = fmaxf(mx, v);
                }
            mx = wmax4(mx, lane);
            const float mnew = fmaxf(mrun[qt], mx); const float alpha = __builtin_amdgcn_exp2f(mrun[qt] - mnew); mrun[qt] = mnew;
            float ps = 0.f;
#pragma unroll
            for (int kt = 0; kt < 4; ++kt)
#pragma unroll
                for (int jj = 0; jj < 4; ++jj) { const float p = __builtin_amdgcn_exp2f(s[kt][jj] - mnew); s[kt][jj] = p; ps += p; }
            lrun[qt] = lrun[qt] * alpha + ps;
            bf16x8 pf[2];
#pragma unroll
            for (int sl = 0; sl < 2; ++sl) { u32x4 pw; pw.x = cvt_pk_bf16(s[2 * sl][0], s[2 * sl][1]); pw.y = cvt_pk_bf16(s[2 * sl][2], s[2 * sl][3]);
                pw.z = cvt_pk_bf16(s[2 * sl + 1][0], s[2 * sl + 1][1]); pw.w = cvt_pk_bf16(s[2 * sl + 1][2], s[2 * sl + 1][3]); pf[sl] = as_bf8(pw); }
#pragma unroll
            for (int dt = 0; dt < 4; ++dt) {
                const bf16x8 v0 = *(const bf16x8*)(vt + (16 * dt + fr) * 72 + 8 * fq), v1 = *(const bf16x8*)(vt + (16 * dt + fr) * 72 + 32 + 8 * fq);
                o[dt][qt] *= alpha; o[dt][qt] = MFMA16(v0, pf[0], o[dt][qt]); o[dt][qt] = MFMA16(v1, pf[1], o[dt][qt]);
            }
        }
        LDSWAIT();
    }
    bf16_t* oa = (bf16_t*)(P.ws + WS_OCAT) + OC_A;
#pragma unroll
    for (int qt = 0; qt < 4; ++qt) {
        const int qi = 16 * qt + fr; const float inv = __builtin_amdgcn_rcpf(wsum4(lrun[qt], lane));
        if (qi < nq) {
            const size_t row = (size_t)(qrow0 + qi);
#pragma unroll
            for (int dt = 0; dt < 4; ++dt) {
                const int d = h * 64 + 16 * dt + 4 * fq;
                const u32x2 gw = *(const u32x2*)(proj + row * NPROJ + C_GA + d);
                const f32x4 v = o[dt][qt] * inv;
                u32x2 ow; ow.x = cvt_pk_bf16(v[0] * siluf_(bflo(gw.x)), v[1] * siluf_(bfhi(gw.x))); ow.y = cvt_pk_bf16(v[2] * siluf_(bflo(gw.y)), v[3] * siluf_(bfhi(gw.y)));
                *(u32x2*)(oa + row * OCW + d) = ow;
            }
        }
    }
}

constexpr int SX_ROW = 0, SX_T = 33792, SB_ROW = 70656, SB_T = 79872, SC_ROW = 89088, S_DT = 98304, S_CUM = 100352, S_SSP = 102400;
__device__ __forceinline__ void ssd_item(int wv, const Params& P, int g, int l, int item, int mode, unsigned char* lds) {
    const bool sample = (mode == 0);
    const int tid = otid(wv), w = tid >> 6, lane = tid & 63, fr = lane & 15, fq = lane >> 4, hh = w >> 1, ph = w & 1;
    const int gi = item & 3, bi = sample ? item >> 2 : item >> 8, c0 = sample ? 0 : (item >> 2) & 63;
    const int row0 = sample ? MP + bi * SL : bi * SEQ, L = sample ? SL : SEQ;
    const int head = 4 * gi + hh;
    const bf16_t* sbuf = (const bf16_t*)(P.ws + WS_SSDS) + ((size_t)(bi * 64 + c0) * 16 + head) * 4096;
    const float a_h = -__expf(P.in[I_ALOG][l * 16 + head]), dtbias = P.in[I_DTB][l * 16 + head], dsk = P.in[I_DSK][l * 16 + head];
    const bf16_t* proj = (const bf16_t*)(P.ws + WS_PROJ); const float* dtbuf = (const float*)(P.ws + WS_DT); bf16_t* ob = (bf16_t*)(P.ws + WS_OCAT) + OC_B;
    bf16_t* Xrow = (bf16_t*)(lds + SX_ROW); bf16_t* Xt = (bf16_t*)(lds + SX_T); bf16_t* Brow = (bf16_t*)(lds + SB_ROW); bf16_t* Bt = (bf16_t*)(lds + SB_T); bf16_t* Crow = (bf16_t*)(lds + SC_ROW);
    float* dtl = (float*)(lds + S_DT) + w * 64; float* cuml = (float*)(lds + S_CUM) + w * 64; float* ssp = (float*)(lds + S_SSP);
    f32x4 hacc[4][2];
#pragma unroll
    for (int nt = 0; nt < 4; ++nt)
#pragma unroll
        for (int pl = 0; pl < 2; ++pl) {
            if (sample) hacc[nt][pl] = *(const f32x4*)(P.in[I_SSM] + (((size_t)(l * NSB + bi) * 16 + head) * 64 + 16 * (2 * ph + pl) + fr) * 64 + 16 * nt + 4 * fq);
            else if (mode == 2) { const u32x2 hw = *(const u32x2*)(sbuf + (16 * (2 * ph + pl) + fr) * 64 + 16 * nt + 4 * fq); hacc[nt][pl] = (f32x4){bflo(hw.x), bfhi(hw.x), bflo(hw.y), bfhi(hw.y)}; }
            else hacc[nt][pl] = (f32x4){0.f, 0.f, 0.f, 0.f};
        }
    const float* gnp = P.in[I_SNG] + l * 1024 + 256 * gi + 64 * hh + 32 * ph + 4 * fq;
    const int cg8 = tid % 48, seg = tid / 48;
    int xch; if (cg8 < 32) xch = 256 * gi + 8 * cg8; else if (cg8 < 40) xch = 1024 + 64 * gi + 8 * (cg8 - 32); else xch = 1280 + 64 * gi + 8 * (cg8 - 40);
    {
        const int t0 = c0 * 64;
        __syncthreads();
        const float dtraw = dtbuf[(size_t)(row0 + ((t0 + lane) < L ? (t0 + lane) : L - 1)) * 16 + head];
        MEMFENCE();
        if (tid < 384) {
            u32x4 rowp[8];
            bf16_t* xact = (bf16_t*)(P.ws + WS_XACT) + (size_t)item * (64 * 384) + (size_t)(8 * seg) * 384 + 8 * cg8;
            if (mode == 2) {
#pragma unroll
                for (int tk = 0; tk < 8; ++tk) rowp[tk] = *(const u32x4*)(xact + tk * 384);
            } else {
            float cw[4][8], acc[8][8];
            { const float* cwp = P.in[I_CWB] + (size_t)l * 4 * 1536 + xch; const float* cbp = P.in[I_CBB] + l * 1536 + xch;
#pragma unroll
              for (int k = 0; k < 4; ++k) { const f32x4 a = *(const f32x4*)(cwp + k * 1536), b = *(const f32x4*)(cwp + k * 1536 + 4); cw[k][0] = a[0]; cw[k][1] = a[1]; cw[k][2] = a[2]; cw[k][3] = a[3]; cw[k][4] = b[0]; cw[k][5] = b[1]; cw[k][6] = b[2]; cw[k][7] = b[3]; }
              const f32x4 a = *(const f32x4*)cbp, b = *(const f32x4*)(cbp + 4);
#pragma unroll
              for (int tk = 0; tk < 8; ++tk) { acc[tk][0] = a[0]; acc[tk][1] = a[1]; acc[tk][2] = a[2]; acc[tk][3] = a[3]; acc[tk][4] = b[0]; acc[tk][5] = b[1]; acc[tk][6] = b[2]; acc[tk][7] = b[3]; } }
#pragma unroll
            for (int r = 0; r < 11; ++r) {
                const int t = t0 + 8 * seg - 3 + r; float xv[8];
                if (t < 0) {
                    if (sample) { const float* sp = P.in[I_SCB] + ((size_t)(l * NSB + bi) * 3 + (3 + t)) * 1536 + xch; const f32x4 a = *(const f32x4*)sp, b = *(const f32x4*)(sp + 4);
                        xv[0] = a[0]; xv[1] = a[1]; xv[2] = a[2]; xv[3] = a[3]; xv[4] = b[0]; xv[5] = b[1]; xv[6] = b[2]; xv[7] = b[3]; }
                    else {
#pragma unroll
                        for (int e = 0; e < 8; ++e) xv[e] = 0.f; }
                } else { const int tl = t < L ? t : L - 1; unpack8(*(const u32x4*)(proj + (size_t)(row0 + tl) * NPROJ + C_XBC + xch), xv); }
#pragma unroll
                for (int k = 0; k < 4; ++k) { const int tk = r - k; if (tk >= 0 && tk < 8) {
#pragma unroll
                    for (int e = 0; e < 8; ++e) acc[tk][e] += cw[k][e] * xv[e]; } }
            }
#pragma unroll
            for (int tk = 0; tk < 8; ++tk)
#pragma unroll
                for (int e = 0; e < 8; ++e) acc[tk][e] = siluf_(acc[tk][e]);
#pragma unroll
                for (int tk = 0; tk < 8; ++tk) rowp[tk] = pack8(acc[tk]);
                if (mode == 1) {
#pragma unroll
                    for (int tk = 0; tk < 8; ++tk) *(u32x4*)(xact + tk * 384) = rowp[tk];
                }
            }
            bf16_t* rdst; int rstride; bf16_t* tdst = nullptr;
            if (cg8 < 32) { rdst = Xrow + 8 * cg8; rstride = 264; tdst = Xt + (8 * cg8) * 72; }
            else if (cg8 < 40) { rdst = Brow + 8 * (cg8 - 32); rstride = 72; tdst = Bt + (8 * (cg8 - 32)) * 72; }
            else { rdst = Crow + 8 * (cg8 - 40); rstride = 72; }
#pragma unroll
            for (int tk = 0; tk < 8; ++tk) *(u32x4*)(rdst + (8 * seg + tk) * rstride) = rowp[tk];
            if (tdst) {
#pragma unroll
                for (int e = 0; e < 8; ++e) { const unsigned sel = (e & 1) ? 0x07060302u : 0x05040100u; u32x4 tw;
                    tw.x = __builtin_amdgcn_perm(rowp[1][e >> 1], rowp[0][e >> 1], sel); tw.y = __builtin_amdgcn_perm(rowp[3][e >> 1], rowp[2][e >> 1], sel);
                    tw.z = __builtin_amdgcn_perm(rowp[5][e >> 1], rowp[4][e >> 1], sel); tw.w = __builtin_amdgcn_perm(rowp[7][e >> 1], rowp[6][e >> 1], sel);
                    *(u32x4*)(tdst + e * 72 + 8 * seg) = tw; }
            }
        }
        { const int t = t0 + lane;
          float dtv = softplusf_(dtraw + dtbias); if (t >= L) dtv = 0.f;
          float cum = dtv * (a_h * 1.44269504f);
#pragma unroll
          for (int off = 1; off < 64; off <<= 1) { const float v = bperm(cum, (lane - off) & 63); if (lane >= off) cum += v; }
          dtl[lane] = dtv; cuml[lane] = cum; }
        __syncthreads();
        const float clast = cuml[63];
        bf16x8 xtf[2][2];
#pragma unroll
        for (int pl = 0; pl < 2; ++pl)
#pragma unroll
            for (int s = 0; s < 2; ++s) xtf[pl][s] = *(const bf16x8*)(Xt + (64 * hh + 16 * (2 * ph + pl) + fr) * 72 + 32 * s + 8 * fq);
        bf16x8 hf[2][2];
#pragma unroll
        for (int s2 = 0; s2 < 2; ++s2)
#pragma unroll
            for (int pl = 0; pl < 2; ++pl) { u32x4 hw; hw.x = cvt_pk_bf16(hacc[2 * s2][pl][0], hacc[2 * s2][pl][1]); hw.y = cvt_pk_bf16(hacc[2 * s2][pl][2], hacc[2 * s2][pl][3]);
                hw.z = cvt_pk_bf16(hacc[2 * s2 + 1][pl][0], hacc[2 * s2 + 1][pl][1]); hw.w = cvt_pk_bf16(hacc[2 * s2 + 1][pl][2], hacc[2 * s2 + 1][pl][3]); hf[s2][pl] = as_bf8(hw); }
        f32x4 vv[2][4];
        if (mode != 1) {
#pragma unroll
        for (int it = 0; it < 4; ++it) {
            const int i = 16 * it + fr; const float ci = cuml[i];
            u32x2 zr[2];
            { const int t = t0 + i; const int tl = t < L ? t : L - 1;
#pragma unroll
              for (int pl = 0; pl < 2; ++pl) zr[pl] = *(const u32x2*)(proj + (size_t)(row0 + tl) * NPROJ + C_Z + 256 * gi + 64 * hh + 16 * (2 * ph + pl) + 4 * fq); }
            const bf16x8 cf0 = *(const bf16x8*)(Crow + i * 72 + 8 * fq), cf1 = *(const bf16x8*)(Crow + i * 72 + 32 + 8 * fq);
            f32x4 ain[2] = {(f32x4){0.f, 0.f, 0.f, 0.f}, (f32x4){0.f, 0.f, 0.f, 0.f}};
#pragma unroll
            for (int s = 0; s < 2; ++s) {
                if (s == 1 && it < 2) continue;
                f32x4 cb[2];
#pragma unroll
                for (int t = 0; t < 2; ++t) { const int jrow = 32 * s + 8 * (fr >> 2) + 4 * t + (fr & 3);
                    const bf16x8 a0 = *(const bf16x8*)(Brow + jrow * 72 + 8 * fq), a1 = *(const bf16x8*)(Brow + jrow * 72 + 32 + 8 * fq);
                    cb[t] = MFMA16(a0, cf0, ((f32x4){0.f, 0.f, 0.f, 0.f})); cb[t] = MFMA16(a1, cf1, cb[t]); }
                float wv[8];
                { const f32x4 ca = *(const f32x4*)(cuml + 32 * s + 8 * fq), cb2 = *(const f32x4*)(cuml + 32 * s + 8 * fq + 4), da = *(const f32x4*)(dtl + 32 * s + 8 * fq), db = *(const f32x4*)(dtl + 32 * s + 8 * fq + 4);
#pragma unroll
                  for (int ii = 0; ii < 8; ++ii) { const int j = 32 * s + 8 * fq + ii; const float cbv = cb[ii >> 2][ii & 3]; const float cjv = ii < 4 ? ca[ii & 3] : cb2[ii & 3], djv = ii < 4 ? da[ii & 3] : db[ii & 3];
                      wv[ii] = (j <= i) ? cbv * __builtin_amdgcn_exp2f(ci - cjv) * djv : 0.f; } }
                const bf16x8 wf = as_bf8(pack8(wv));
#pragma unroll
                for (int pl = 0; pl < 2; ++pl) ain[pl] = MFMA16(xtf[pl][s], wf, ain[pl]);
            }
            f32x4 ast[2] = {(f32x4){0.f, 0.f, 0.f, 0.f}, (f32x4){0.f, 0.f, 0.f, 0.f}};
#pragma unroll
            for (int s2 = 0; s2 < 2; ++s2) { const u32x2 c0 = *(const u32x2*)(Crow + i * 72 + 32 * s2 + 4 * fq), c1 = *(const u32x2*)(Crow + i * 72 + 32 * s2 + 16 + 4 * fq);
                u32x4 cw4; cw4.x = c0.x; cw4.y = c0.y; cw4.z = c1.x; cw4.w = c1.y; const bf16x8 cf2 = as_bf8(cw4);
#pragma unroll
                for (int pl = 0; pl < 2; ++pl) ast[pl] = MFMA16(hf[s2][pl], cf2, ast[pl]); }
            const float ei = __builtin_amdgcn_exp2f(ci); float sq = 0.f;
#pragma unroll
            for (int pl = 0; pl < 2; ++pl) { const u32x2 xw = *(const u32x2*)(Xrow + i * 264 + 64 * hh + 16 * (2 * ph + pl) + 4 * fq);
                const float x0 = bflo(xw.x), x1 = bfhi(xw.x), x2 = bflo(xw.y), x3 = bfhi(xw.y); const u32x2 zw = zr[pl];
                f32x4 y; y[0] = (ain[pl][0] + ei * ast[pl][0] + dsk * x0) * siluf_(bflo(zw.x)); y[1] = (ain[pl][1] + ei * ast[pl][1] + dsk * x1) * siluf_(bfhi(zw.x));
                y[2] = (ain[pl][2] + ei * ast[pl][2] + dsk * x2) * siluf_(bflo(zw.y)); y[3] = (ain[pl][3] + ei * ast[pl][3] + dsk * x3) * siluf_(bfhi(zw.y));
                vv[pl][it] = y; sq += (y[0] * y[0] + y[1] * y[1]) + (y[2] * y[2] + y[3] * y[3]); }
            sq = wsum4(sq, lane); if (fq == 0) ssp[w * 64 + i] = sq;
        }
        }
        if (mode != 2) { const float el = __builtin_amdgcn_exp2f(clast);
          if (mode == 1 && ph == 0 && lane == 0) ((float*)(P.ws + WS_ACB))[(size_t)(bi * 64 + c0) * 16 + head] = el;
#pragma unroll
          for (int nt = 0; nt < 4; ++nt)
#pragma unroll
              for (int pl = 0; pl < 2; ++pl) hacc[nt][pl] *= el;
#pragma unroll
          for (int s = 0; s < 2; ++s) {
              float dl[8];
              { const f32x4 ca = *(const f32x4*)(cuml + 32 * s + 8 * fq), cb2 = *(const f32x4*)(cuml + 32 * s + 8 * fq + 4), da = *(const f32x4*)(dtl + 32 * s + 8 * fq), db = *(const f32x4*)(dtl + 32 * s + 8 * fq + 4);
#pragma unroll
                for (int ii = 0; ii < 4; ++ii) { dl[ii] = __builtin_amdgcn_exp2f(clast - ca[ii]) * da[ii]; dl[4 + ii] = __builtin_amdgcn_exp2f(clast - cb2[ii]) * db[ii]; } }
#pragma unroll
              for (int pl = 0; pl < 2; ++pl) { float xf[8]; union { bf16x8 b; u32x4 u; } cv; cv.b = xtf[pl][s]; unpack8(cv.u, xf);
#pragma unroll
                  for (int ii = 0; ii < 8; ++ii) xf[ii] *= dl[ii];
                  const bf16x8 xdf = as_bf8(pack8(xf));
#pragma unroll
                  for (int nt = 0; nt < 4; ++nt) { const bf16x8 btf = *(const bf16x8*)(Bt + (16 * nt + fr) * 72 + 32 * s + 8 * fq); hacc[nt][pl] = MFMA16(btf, xdf, hacc[nt][pl]); } }
          } }
        f32x4 gnv[2]; gnv[0] = *(const f32x4*)gnp; gnv[1] = *(const f32x4*)(gnp + 16);
        MEMFENCE();
        __syncthreads();
        if (mode != 1) {
#pragma unroll
        for (int it = 0; it < 4; ++it) { const int i = 16 * it + fr; float tot = 0.f;
#pragma unroll
            for (int ww = 0; ww < 8; ++ww) tot += ssp[ww * 64 + i];
            const float r = __builtin_amdgcn_rsqf(tot * (1.0f / 256.0f) + EPSN);
            if (t0 + i < L) {
#pragma unroll
                for (int pl = 0; pl < 2; ++pl) { const f32x4 q = vv[pl][it] * r * gnv[pl]; u32x2 ow; ow.x = cvt_pk_bf16(q[0], q[1]); ow.y = cvt_pk_bf16(q[2], q[3]);
                    *(u32x2*)(ob + (size_t)(row0 + t0 + i) * OCW + 256 * gi + 64 * hh + 16 * (2 * ph + pl) + 4 * fq) = ow; } }
        }
        }
    }
    { const int tid2 = otid(wv), w2 = tid2 >> 6, lane2 = tid2 & 63, fr2 = lane2 & 15, fq2 = lane2 >> 4, hh2 = w2 >> 1, ph2 = w2 & 1, head2 = 4 * gi + hh2;
      if (mode == 0) {
          float* so = P.out + O_SSS + ((size_t)(l * NSB + bi) * 16 + head2) * 4096;
#pragma unroll
          for (int nt = 0; nt < 4; ++nt)
#pragma unroll
              for (int pl = 0; pl < 2; ++pl) *(f32x4*)(so + (16 * (2 * ph2 + pl) + fr2) * 64 + 16 * nt + 4 * fq2) = hacc[nt][pl];
      } else if (mode == 1) {
          bf16_t* so = (bf16_t*)(P.ws + WS_SSDS) + ((size_t)(bi * 64 + c0) * 16 + head2) * 4096;
#pragma unroll
          for (int nt = 0; nt < 4; ++nt)
#pragma unroll
              for (int pl = 0; pl < 2; ++pl) { u32x2 hw; hw.x = cvt_pk_bf16(hacc[nt][pl][0], hacc[nt][pl][1]); hw.y = cvt_pk_bf16(hacc[nt][pl][2], hacc[nt][pl][3]);
                  *(u32x2*)(so + (16 * (2 * ph2 + pl) + fr2) * 64 + 16 * nt + 4 * fq2) = hw; }
      }
      if (sample || (mode == 2 && c0 == 63)) {
          float* co = sample ? P.out + O_SCB + (size_t)(l * NSB + bi) * 3 * 1536 : P.out + O_PCB + (size_t)(l * NB + g * GB + bi) * 3 * 1536;
          for (int idx = tid2; idx < 3 * 384; idx += 512) { const int r = idx / 384, ci = idx % 384;
              const int xc = ci < 256 ? 256 * gi + ci : (ci < 320 ? 1024 + 64 * gi + (ci - 256) : 1280 + 64 * gi + (ci - 320));
              co[r * 1536 + xc] = bf1(proj[(size_t)(row0 + L - 3 + r) * NPROJ + C_XBC + xc]); } } }
}

__device__ __forceinline__ void ssd_scan(int wv, const Params& P, int g, int l) {
    const int tid = otid(wv);
    unsigned* sb = (unsigned*)(P.ws + WS_SSDS); const float* acb = (const float*)(P.ws + WS_ACB);
    for (int e = blockIdx.x * 512 + tid; e < GB * 16 * 2048; e += gridDim.x * 512) {
        const int bi = e >> 15, head = (e >> 11) & 15, idx = e & 2047;
        unsigned* p0 = sb + ((size_t)(bi * 64) * 16 + head) * 2048 + idx; const float* a0 = acb + (bi * 64) * 16 + head;
        float H0 = 0.f, H1 = 0.f;
#pragma unroll 1
        for (int cb = 0; cb < 64; cb += 16) {
            unsigned S[16]; float A[16];
#pragma unroll
            for (int c = 0; c < 16; ++c) { S[c] = p0[(size_t)(cb + c) * 16 * 2048]; A[c] = a0[(cb + c) * 16]; }
            MEMFENCE();
#pragma unroll
            for (int c = 0; c < 16; ++c) { p0[(size_t)(cb + c) * 16 * 2048] = cvt_pk_bf16(H0, H1); H0 = A[c] * H0 + bflo(S[c]); H1 = A[c] * H1 + bfhi(S[c]); }
            MEMFENCE();
        }
        float* o = P.out + O_PSS + ((size_t)(l * NB + g * GB + bi) * 16 + head) * 4096 + 2 * idx; o[0] = H0; o[1] = H1;
    }
}

constexpr int LX_C = 0, LX_F = 17408, LH_O = 51200;
constexpr int LP_O = 84992;
__device__ __forceinline__ void lru_item(int wv, const Params& P, int g, int l, int item, int mode, unsigned char* lds) {
    const bool sample = (mode == 0);
    const int tid = otid(wv), w = tid >> 6, lane = tid & 63, fr = lane & 15, fq = lane >> 4;
    const int kp = item & 3, bi = sample ? item >> 2 : item >> 8, c0 = sample ? 0 : (item >> 2) & 63;
    const int row0 = sample ? MP + bi * SL : bi * SEQ, L = sample ? SL : SEQ;
    const int kb = 2 * kp + (w >> 2), ct = w & 3, c = 64 * kb + 16 * ct + fr, cl = c - 128 * kp;
    const bf16_t* proj = (const bf16_t*)(P.ws + WS_PROJ); bf16_t* oc = (bf16_t*)(P.ws + WS_OCAT) + OC_C;
    bf16_t* XC = (bf16_t*)(lds + LX_C); float* XCF = (float*)(lds + LX_F); float* HOUT = (float*)(lds + LH_O); float* POUT = (float*)(lds + LP_O);
    bf16x8 wrf[2], wif[2];
    { const u32x4* wf = (const u32x4*)(P.ws + WS_LWF) + (size_t)((l * 8 + kb) * 4 + ct) * 256 + lane;
      wrf[0] = as_bf8(wf[0]); wif[0] = as_bf8(wf[64]); wrf[1] = as_bf8(wf[128]); wif[1] = as_bf8(wf[192]); }
    const float br = P.in[I_BRG][l * 512 + c], bi_ = P.in[I_BIG][l * 512 + c], sp = softplusf_(-P.in[I_LAM][l * 512 + c]), spl2 = -8.0f * 1.44269504f * sp, sp16 = -16.0f * sp;
    float hstate = sample ? P.in[I_SLR][(size_t)(l * NSB + bi) * 512 + c] : 0.f, pstate = 1.f;
    const int cg8 = tid & 15, tp = tid >> 4, xch = 128 * kp + 8 * cg8;
    {
        const int t0 = c0 * 64;
        {
            float cw[4][8], acc[2][8];
            const float* cwp = P.in[I_CWC] + (size_t)l * 4 * 512 + xch; const float* cbp = P.in[I_CBC] + l * 512 + xch;
#pragma unroll
            for (int k = 0; k < 4; ++k) { const f32x4 a = *(const f32x4*)(cwp + k * 512), b = *(const f32x4*)(cwp + k * 512 + 4); cw[k][0] = a[0]; cw[k][1] = a[1]; cw[k][2] = a[2]; cw[k][3] = a[3]; cw[k][4] = b[0]; cw[k][5] = b[1]; cw[k][6] = b[2]; cw[k][7] = b[3]; }
            { const f32x4 a = *(const f32x4*)cbp, b = *(const f32x4*)(cbp + 4);
#pragma unroll
              for (int tk = 0; tk < 2; ++tk) { acc[tk][0] = a[0]; acc[tk][1] = a[1]; acc[tk][2] = a[2]; acc[tk][3] = a[3]; acc[tk][4] = b[0]; acc[tk][5] = b[1]; acc[tk][6] = b[2]; acc[tk][7] = b[3]; } }
#pragma unroll
            for (int r = 0; r < 5; ++r) {
                const int t = t0 + 2 * tp - 3 + r; float xv[8];
                if (t < 0) {
                    if (sample) { const float* sp2 = P.in[I_SCC] + ((size_t)(l * NSB + bi) * 3 + (3 + t)) * 512 + xch; const f32x4 a = *(const f32x4*)sp2, b = *(const f32x4*)(sp2 + 4);
                        xv[0] = a[0]; xv[1] = a[1]; xv[2] = a[2]; xv[3] = a[3]; xv[4] = b[0]; xv[5] = b[1]; xv[6] = b[2]; xv[7] = b[3]; }
                    else {
#pragma unroll
                        for (int e = 0; e < 8; ++e) xv[e] = 0.f; }
                } else { const int tl = t < L ? t : L - 1; unpack8(*(const u32x4*)(proj + (size_t)(row0 + tl) * NPROJ + C_XC + xch), xv); }
#pragma unroll
                for (int k = 0; k < 4; ++k) { const int tk = r - k; if (tk >= 0 && tk < 2) {
#pragma unroll
                    for (int e = 0; e < 8; ++e) acc[tk][e] += cw[k][e] * xv[e]; } }
            }
#pragma unroll
            for (int tk = 0; tk < 2; ++tk) { const int tok = 2 * tp + tk;
                *(u32x4*)(XC + tok * 136 + 8 * cg8) = pack8(acc[tk]);
                *(f32x4*)(XCF + tok * 132 + 8 * cg8) = (f32x4){acc[tk][0], acc[tk][1], acc[tk][2], acc[tk][3]}; *(f32x4*)(XCF + tok * 132 + 8 * cg8 + 4) = (f32x4){acc[tk][4], acc[tk][5], acc[tk][6], acc[tk][7]}; }
        }
        __syncthreads();
#pragma unroll
        for (int tt = 0; tt < 4; ++tt) {
            const bf16x8 a0 = *(const bf16x8*)(XC + (16 * tt + fr) * 136 + 64 * (w >> 2) + 8 * fq), a1 = *(const bf16x8*)(XC + (16 * tt + fr) * 136 + 64 * (w >> 2) + 32 + 8 * fq);
            f32x4 ar = MFMA16(a0, wrf[0], ((f32x4){0.f, 0.f, 0.f, 0.f})); ar = MFMA16(a1, wrf[1], ar);
            f32x4 ai = MFMA16(a0, wif[0], ((f32x4){0.f, 0.f, 0.f, 0.f})); ai = MFMA16(a1, wif[1], ai);
            float as_[4], bs_[4]; float A = 1.f, B = 0.f;
#pragma unroll
            for (int jj = 0; jj < 4; ++jj) { const int tok = 16 * tt + 4 * fq + jj; const float xf = XCF[tok * 132 + cl];
                const float r = sigmoidf_(ar[jj] + br), ig = sigmoidf_(ai[jj] + bi_); float a = __builtin_amdgcn_exp2f(r * spl2); const float x2 = r * sp16; float mult = __builtin_amdgcn_sqrtf(x2 > -0.05f ? -x2 * (1.0f + x2 * (0.5f + x2 * 0.16666667f)) : 1.0f - a * a);
                if (!sample && t0 + tok == 0) mult = 1.0f;
                float bt = mult * ig * xf; if (t0 + tok >= L) { a = 1.f; bt = 0.f; }
                B = a * B + bt; A = A * a; as_[jj] = A; bs_[jj] = B; }
            float carry = hstate, mycarry = 0.f, pcarry = pstate, mypc = 1.f;
#pragma unroll
            for (int k = 0; k < 4; ++k) { const float Ak = bperm(A, fr + 16 * k), Bk = bperm(B, fr + 16 * k); if (k == fq) { mycarry = carry; mypc = pcarry; } carry = Ak * carry + Bk; pcarry = Ak * pcarry; }
            hstate = carry; pstate = pcarry;
#pragma unroll
            for (int jj = 0; jj < 4; ++jj) { HOUT[(16 * tt + 4 * fq + jj) * 132 + cl] = bs_[jj] + as_[jj] * mycarry; if (mode == 1) POUT[(16 * tt + 4 * fq + jj) * 132 + cl] = as_[jj] * mypc; }
        }
        __syncthreads();
#pragma unroll
        for (int tk = 0; tk < 2; ++tk) { const int tok = 2 * tp + tk, t = t0 + tok;
            if (t < L) { const f32x4 h0 = *(const f32x4*)(HOUT + tok * 132 + 8 * cg8), h1 = *(const f32x4*)(HOUT + tok * 132 + 8 * cg8 + 4);
                if (mode == 1) {
                    bf16_t* hz = (bf16_t*)(P.ws + WS_HZ) + (size_t)(row0 + t) * 512 + xch; bf16_t* pz = (bf16_t*)(P.ws + WS_PZ) + (size_t)(row0 + t) * 512 + xch;
                    const f32x4 q0 = *(const f32x4*)(POUT + tok * 132 + 8 * cg8), q1 = *(const f32x4*)(POUT + tok * 132 + 8 * cg8 + 4);
                    u32x4 hw; hw.x = cvt_pk_bf16(h0[0], h0[1]); hw.y = cvt_pk_bf16(h0[2], h0[3]); hw.z = cvt_pk_bf16(h1[0], h1[1]); hw.w = cvt_pk_bf16(h1[2], h1[3]); *(u32x4*)hz = hw;
                    u32x4 pw; pw.x = cvt_pk_bf16(q0[0], q0[1]); pw.y = cvt_pk_bf16(q0[2], q0[3]); pw.z = cvt_pk_bf16(q1[0], q1[1]); pw.w = cvt_pk_bf16(q1[2], q1[3]); *(u32x4*)pz = pw;
                } else {
                float gf[8]; unpack8(*(const u32x4*)(proj + (size_t)(row0 + t) * NPROJ + C_GC + xch), gf);
                u32x4 ow; ow.x = cvt_pk_bf16(h0[0] * siluf_(gf[0]), h0[1] * siluf_(gf[1])); ow.y = cvt_pk_bf16(h0[2] * siluf_(gf[2]), h0[3] * siluf_(gf[3]));
                ow.z = cvt_pk_bf16(h1[0] * siluf_(gf[4]), h1[1] * siluf_(gf[5])); ow.w = cvt_pk_bf16(h1[2] * siluf_(gf[6]), h1[3] * siluf_(gf[7]));
                *(u32x4*)(oc + (size_t)(row0 + t) * OCW + xch) = ow; } } }
    }
    if (mode == 1) {
        if (fq == 0) { ((float*)(P.ws + WS_LCA))[(size_t)(bi * 64 + c0) * 512 + c] = pstate; ((float*)(P.ws + WS_LCB))[(size_t)(bi * 64 + c0) * 512 + c] = hstate; }
    } else {
      float* lo = P.out + O_SLR + (size_t)(l * NSB + bi) * 512;
      if (fq == 0) lo[c] = hstate;
      float* co = P.out + O_SCC + (size_t)(l * NSB + bi) * 3 * 512;
      if (tid < 384) { const int r = tid >> 7, ci = tid & 127; co[r * 512 + 128 * kp + ci] = bf1(proj[(size_t)(row0 + L - 3 + r) * NPROJ + C_XC + 128 * kp + ci]); } }
    __syncthreads();
}

__device__ __forceinline__ void lru_scan(int wv, const Params& P, int g, int l) {
    const int tid = otid(wv); const int e = blockIdx.x * 512 + tid;
    const float* lca = (const float*)(P.ws + WS_LCA); float* lcb = (float*)(P.ws + WS_LCB); const bf16_t* proj = (const bf16_t*)(P.ws + WS_PROJ);
    if (e < GB * 512) {
        const int bi = e >> 9, chn = e & 511; float carry = 0.f;
#pragma unroll 1
        for (int cb = 0; cb < 64; cb += 16) {
            float A[16], B[16];
#pragma unroll
            for (int c = 0; c < 16; ++c) { const size_t o = (size_t)(bi * 64 + cb + c) * 512 + chn; A[c] = lca[o]; B[c] = lcb[o]; }
            MEMFENCE();
#pragma unroll
            for (int c = 0; c < 16; ++c) { lcb[(size_t)(bi * 64 + cb + c) * 512 + chn] = carry; carry = A[c] * carry + B[c]; }
            MEMFENCE();
        }
        P.out[O_PLR + (size_t)(l * NB + g * GB + bi) * 512 + chn] = carry;
    } else if (e < GB * 512 + GB * 3 * 512) {
        const int q = e - GB * 512, bi = q / 1536, r = (q % 1536) >> 9, chn = q & 511;
        P.out[O_PCC + ((size_t)(l * NB + g * GB + bi) * 3 + r) * 512 + chn] = bf1(proj[(size_t)(bi * SEQ + SEQ - 3 + r) * NPROJ + C_XC + chn]);
    }
}
__device__ __forceinline__ void lru_apply(int wv, const Params& P) {
    const int tid = otid(wv);
    const bf16_t* hzb = (const bf16_t*)(P.ws + WS_HZ); const bf16_t* pzb = (const bf16_t*)(P.ws + WS_PZ); const float* lcb = (const float*)(P.ws + WS_LCB);
    const bf16_t* proj = (const bf16_t*)(P.ws + WS_PROJ); bf16_t* oc = (bf16_t*)(P.ws + WS_OCAT) + OC_C;
    for (int u = blockIdx.x * 512 + tid; u < MP * 64; u += gridDim.x * 512) {
        const int row = u >> 6, cg = u & 63; const size_t o = (size_t)row * 512 + 8 * cg;
        float hf[8], pf8[8]; unpack8(*(const u32x4*)(hzb + o), hf); unpack8(*(const u32x4*)(pzb + o), pf8);
        const f32x4 h0 = (f32x4){hf[0], hf[1], hf[2], hf[3]}, h1 = (f32x4){hf[4], hf[5], hf[6], hf[7]}, p0 = (f32x4){pf8[0], pf8[1], pf8[2], pf8[3]}, p1 = (f32x4){pf8[4], pf8[5], pf8[6], pf8[7]};
        const float* cp = lcb + (size_t)(row >> 6) * 512 + 8 * cg; const f32x4 c0 = *(const f32x4*)cp, c1 = *(const f32x4*)(cp + 4);
        float gf[8]; unpack8(*(const u32x4*)(proj + (size_t)row * NPROJ + C_GC + 8 * cg), gf);
        const f32x4 a = h0 + p0 * c0, b = h1 + p1 * c1;
        u32x4 ow; ow.x = cvt_pk_bf16(a[0] * siluf_(gf[0]), a[1] * siluf_(gf[1])); ow.y = cvt_pk_bf16(a[2] * siluf_(gf[2]), a[3] * siluf_(gf[3]));
        ow.z = cvt_pk_bf16(b[0] * siluf_(gf[4]), b[1] * siluf_(gf[5])); ow.w = cvt_pk_bf16(b[2] * siluf_(gf[6]), b[3] * siluf_(gf[7]));
        *(u32x4*)(oc + (size_t)row * OCW + 8 * cg) = ow;
    }
}

__device__ __forceinline__ void phase_mix1(int wv, const Params& P, int g, int l, unsigned char* lds, bool with_smp, int rep = 0) {
    unsigned* ctr = (unsigned*)(P.ws + WS_CTR) + (g * 2 + l) * 16 + rep * 4;
    int* slot = (int*)(lds + 163776);
    const int n_att = GB * 64, n_smp = with_smp ? (8 + 32 + 32) : 0, n_ssd = GB * 64 * 4, n_lru = GB * 64 * 4;
    const int total = n_att + n_smp + n_ssd + n_lru;
    for (;;) {
        __syncthreads();
        if (otid(wv) == 0) *slot = (int)atomicAdd(ctr, 1u);
        __syncthreads();
        int it = *slot;
        if (it >= total) break;
#ifdef PROBE_ATT2
        if (it < n_att) { attn_item(wv, P, g, l, ((it & 63) ^ 63) | (it & ~63), false, lds); __syncthreads(); attn_item(wv, P, g, l, ((it & 63) ^ 63) | (it & ~63), false, lds); continue; }
#endif
        if (it < n_att) { attn_item(wv, P, g, l, ((it & 63) ^ 63) | (it & ~63), false, lds); continue; }
        it -= n_att;
        if (with_smp) {
            if (it < 8) { attn_item(wv, P, g, l, it, true, lds); continue; }
            it -= 8;
            if (it < 32) { ssd_item(wv, P, g, l, it, 0, lds); continue; }
            it -= 32;
            if (it < 32) { lru_item(wv, P, g, l, it, 0, lds); continue; }
            it -= 32;
        }
#ifdef PROBE_SSDA2
        if (it < n_ssd) { ssd_item(wv, P, g, l, it, 1, lds); ssd_item(wv, P, g, l, it, 1, lds); continue; }
#endif
        if (it < n_ssd) { ssd_item(wv, P, g, l, it, 1, lds); continue; }
        it -= n_ssd;
#ifdef PROBE_LRUA2
        lru_item(wv, P, g, l, it, 1, lds); __syncthreads();
#endif
        lru_item(wv, P, g, l, it, 1, lds);
    }
}
__device__ __forceinline__ void phase_smpmix(int wv, const Params& P, int l, unsigned char* lds) {
    unsigned* ctr = (unsigned*)(P.ws + WS_CTR) + l * 16 + 12;
    int* slot = (int*)(lds + 163776);
    for (;;) {
        __syncthreads();
        if (otid(wv) == 0) *slot = (int)atomicAdd(ctr, 1u);
        __syncthreads();
        int it = *slot;
        if (it >= 72) break;
        if (it < 8) { attn_item(wv, P, 0, l, it, true, lds); continue; }
        it -= 8;
        if (it < 32) { ssd_item(wv, P, 0, l, it, 0, lds); continue; }
        it -= 32;
        lru_item(wv, P, 0, l, it, 0, lds);
    }
}
__device__ __forceinline__ void phase_mix3(int wv, const Params& P, int g, int l, unsigned char* lds, int rep = 0) {
    for (int it = (int)blockIdx.x; it < GB * 64 * 4; it += (int)gridDim.x) { __syncthreads(); ssd_item(wv, P, g, l, it, 2, lds); }
    __syncthreads();
    lru_apply(wv, P);
}

struct SampleOrder { int idx, n;
    __device__ __forceinline__ bool next(int i, Unit& u) const { if (i != 0 || idx < 0 || idx >= n) return false; u.pm = MP / BM; u.pn = idx; return true; }
    __device__ __forceinline__ void a_ready(const Unit&) const {}
    __device__ __forceinline__ void done(const Unit&) const {} };

template <class Sched> __device__ __forceinline__ void st_p1(int wv, PG8_LAS unsigned char* glds, const Sched& S, int g, int l) {
    const Params P = load_params(); float* ssn = (float*)(P.ws + WS_SS) + (size_t)(g * 4 + l * 2 + 0) * MLOC;
    Gemm gm{(const bf16_t*)(P.ws + WS_HBUF), (const bf16_t*)(P.ws + WS_WIN) + (size_t)l * NWIN * 1024, MP, NWIN, 1024, wv};
    EpiIn E{(bf16_t*)(P.ws + WS_PROJ), (float*)(P.ws + WS_DT), ssn};
    GEMMCALL<EpiIn, Sched, false>(glds, gm, S, E, nullptr);
}
template <class Sched> __device__ __forceinline__ void st_p3(int wv, PG8_LAS unsigned char* glds, const Sched& S, int l) {
    const Params P = load_params(); bf16_t* proj = (bf16_t*)(P.ws + WS_PROJ);
    { Gemm gm{(const bf16_t*)(P.ws + WS_OCAT), (const bf16_t*)(P.ws + WS_WCAT) + (size_t)l * 1024 * 2048, MP, 1024, 2048, wv};
      EpiMergeF E{proj + C_GM, (bf16_t*)(P.ws + WS_MIXB)}; GEMMCALL<EpiMergeF, Sched, false>(glds, gm, S, E, nullptr); }
    { Gemm gm{(const bf16_t*)(P.ws + WS_PBUF) + (size_t)l * MLOC * 256, (const bf16_t*)(P.ws + WS_WPP) + (size_t)l * 1024 * 256, MP, 1024, 256, wv};
      EpiPP E{(bf16_t*)(P.ws + WS_PP)}; GEMMCALL<EpiPP, Sched, false>(glds, gm, S, E, nullptr); }
}
template <class Sched> __device__ __forceinline__ void st_p4(int wv, PG8_LAS unsigned char* glds, const Sched& S, int g, int l) {
    const Params P = load_params(); float* ssp = (float*)(P.ws + WS_SS) + (size_t)(g * 4 + l * 2 + 1) * MLOC;
    Gemm gm{(const bf16_t*)(P.ws + WS_MIXB), (const bf16_t*)(P.ws + WS_WOUT) + (size_t)l * 1024 * 1024, MP, 1024, 1024, wv};
    const float* xa = P.in[I_XP] + (size_t)g * MP * DM; const float* xb = P.in[I_XS];
    EpiOut E{xa, xb, (bf16_t*)(P.ws + WS_XRES), (bf16_t*)(P.ws + WS_UBUF), P.in[I_PNG] + l * 1024, ssp, l == 0 ? 1 : 0};
    GEMMCALL<EpiOut, Sched, false>(glds, gm, S, E, nullptr);
}
template <class Sched> __device__ __forceinline__ void st_p6(int wv, PG8_LAS unsigned char* glds, const Sched& S, int g, int l) {
    const Params P = load_params(); float* ssp = (float*)(P.ws + WS_SS) + (size_t)(g * 4 + l * 2 + 1) * MLOC;
    Gemm gm{(const bf16_t*)(P.ws + WS_UBUF), (const bf16_t*)(P.ws + WS_WPG) + (size_t)l * 1024 * 1024, MP, 1024, 1024, wv};
    float* ya = P.out + O_YP + (size_t)g * MP * DM; float* yb = P.out + O_YS;
    EpiGate E{ya, yb, (const bf16_t*)(P.ws + WS_PP), ssp, (l == 0) ? (bf16_t*)(P.ws + WS_HBUF) : nullptr, P.in[I_NG] + 1024, (float*)(P.ws + WS_SS) + (size_t)(g * 4 + 2) * MLOC, (bf16_t*)(P.ws + WS_XRES)};
    GEMMCALL<EpiGate, Sched, false>(glds, gm, S, E, nullptr);
}

__global__ void __launch_bounds__(512) fwd_megakernel(Params Parg) {
    extern __shared__ __attribute__((aligned(16))) unsigned char shm[];
    cg::grid_group grid = cg::this_grid();
    PG8_LAS unsigned char* glds = (PG8_LAS unsigned char*)shm;
    const int G = (int)gridDim.x, cidx = (int)blockIdx.x; const int wv = __builtin_amdgcn_readfirstlane((int)(threadIdx.x >> 6));
    volatile unsigned* bst = (volatile unsigned*)(shm + 163792);
    if (otid(wv) == 0) { bst[0] = 0u; bst[1] = 0u; }
    __syncthreads();
    { const Params P = load_params(); phase_weights(wv, P, shm); }
    { const Params P = load_params(); phase_prep(wv, P, 0); }
    grid.sync();
    { const Params P = load_params(); if (otid(wv) == 0) (void)xb_add(&((unsigned*)(P.ws + WS_BAR))[XB_XCNT(xb_xcc_id())], 1u); }
#ifdef PROBE_T
    unsigned long long tacc = 0, tbeg = 0;
#define TBEG(k) do { if (PROBE_T == (k)) tbeg = __builtin_amdgcn_s_memrealtime(); } while (0)
#define TEND(k) do { if (PROBE_T == (k)) tacc += __builtin_amdgcn_s_memrealtime() - tbeg; } while (0)
#else
#define TBEG(k) do {} while (0)
#define TEND(k) do {} while (0)
#endif
#define GSYNC() do { TBEG(1); const Params Pb = load_params(); xcd_sync(wv, (unsigned*)(Pb.ws + WS_BAR), bst); TEND(1); } while (0)
#pragma unroll 1
    for (int g = 0; g < NG; ++g) {
#pragma unroll 1
        for (int l = 0; l < 2; ++l) {
            const int key = g * 2 + l;
            { StaticOrder S; S.init(MP, NWIN, G, cidx); st_p1(wv, glds, S, g, l); }
            const int coff = (G > 226) ? 192 : 0;
            if (key == 0) { SampleOrder So{cidx - coff, 35}; st_p1(wv, glds, So, 0, 0); }
            if (key == 1) { SampleOrder So{cidx - coff, 4}; st_p6(wv, glds, So, 0, 0); }
            if (key == 2) { SampleOrder So{cidx - coff, 4}; st_p4(wv, glds, So, 0, 1); }
            GSYNC();
            if (key == 1) { SampleOrder So{cidx, 35}; st_p1(wv, glds, So, 0, 1); }
            if (key == 2) { SampleOrder So{cidx, 4}; st_p6(wv, glds, So, 0, 1); }
            { const Params P = load_params(); phase_mix1(wv, P, g, l, shm, key == 0); }
            GSYNC();
            if (key == 0) { SampleOrder So{cidx, 4}; st_p3(wv, glds, So, 0); }
            if (key == 1) { const Params P = load_params(); phase_smpmix(wv, P, 1, shm); }
            TBEG(3); { const Params P = load_params(); ssd_scan(wv, P, g, l); lru_scan(wv, P, g, l); } TEND(3);
            GSYNC();
            if (key == 0) { SampleOrder So{cidx, 4}; st_p4(wv, glds, So, 0, 0); }
            if (key == 1) { SampleOrder So{cidx, 4}; st_p3(wv, glds, So, 1); }
            { const Params P = load_params(); phase_mix3(wv, P, g, l, shm); }
            GSYNC();
            TBEG(4); { StaticOrder S; S.init(MP, 1024, G, cidx); st_p3(wv, glds, S, l); } TEND(4);
            GSYNC();
            TBEG(2); { StaticOrder S; S.init(MP, 1024, G, cidx); st_p4(wv, glds, S, g, l); } TEND(2);
            GSYNC();
            TBEG(2); { StaticOrder S; S.init(MP, 1024, G, cidx); st_p6(wv, glds, S, g, l); } TEND(2);
            if (l == 1 && g + 1 < NG) { const Params P = load_params(); phase_prep(wv, P, g + 1); }
            GSYNC();
        }
    }
#ifdef PROBE_T
    if (blockIdx.x == 0 && otid(wv) == 0) { const Params P = load_params(); P.out[O_YP + 5] += (float)tacc * 1e-4f; }
#endif
}


constexpr int LDS_BYTES = 163840;

extern "C" void kernel_launch(void* const* d_in, const int* in_sizes, int n_in, void* d_out, int out_size, void* d_ws, size_t ws_size, hipStream_t stream) {
    static int grid_blocks = 0;
    if (grid_blocks == 0) {
        if (n_in != 35 || (size_t)out_size != O_END || ws_size < WS_END) { fprintf(stderr, "kernel_launch: unexpected shapes: n_in %d out %d ws %zu (need %zu)\n", n_in, out_size, ws_size, (size_t)WS_END); grid_blocks = -1; return; }
        int dev = 0, cus = 0, per_cu = 0;
        hipGetDevice(&dev); hipDeviceGetAttribute(&cus, hipDeviceAttributeMultiprocessorCount, dev);
        if (hipFuncSetAttribute((const void*)fwd_megakernel, hipFuncAttributeMaxDynamicSharedMemorySize, LDS_BYTES) != hipSuccess) { fprintf(stderr, "kernel_launch: hipFuncSetAttribute failed\n"); grid_blocks = -1; return; }
        if (hipOccupancyMaxActiveBlocksPerMultiprocessor(&per_cu, (const void*)fwd_megakernel, 512, LDS_BYTES) != hipSuccess || per_cu < 1) { fprintf(stderr, "kernel_launch: occupancy query gives %d\n", per_cu); per_cu = 1; }
        (void)hipGetLastError();
        grid_blocks = cus;
        if (grid_blocks < 35) { fprintf(stderr, "kernel_launch: this kernel needs at least 35 workgroups (device reports %d CUs)\n", cus); grid_blocks = -1; return; }
    }
    if (grid_blocks < 0) return;
    Params p{};
    for (int i = 0; i < 35; ++i) p.in[i] = (const float*)d_in[i];
    p.out = (float*)d_out; p.ws = (unsigned char*)d_ws;
    void* args[] = {&p};
    hipError_t e = hipLaunchCooperativeKernel((const void*)fwd_megakernel, dim3(grid_blocks), dim3(512), args, LDS_BYTES, stream);
    if (e != hipSuccess) fprintf(stderr, "cooperative launch failed: %s (grid %d)\n", hipGetErrorString(e), grid_blocks);
}
```
